# Optimizing an MI355X kernel written in HIP

```python
import math
import jax, jax.numpy as jnp
from jax import lax
import numpy as np

D_MODEL = 2048
BATCH = 8
SEQ = 4096
DEPTH = 2

ATTN_HEADS = 8
ATTN_QK_DIM = 64
ATTN_V_DIM = 2 * ATTN_QK_DIM
ATTN_WIDTH = ATTN_HEADS * ATTN_V_DIM
Q_BLOCK = 128
SSM_WIDTH = D_MODEL // 2
SSM_GROUP = 16
SSM_GROUPS = SSM_WIDTH // SSM_GROUP
SSM_STATE = 64
DT_MIN = 1e-3
DT_MAX = 1e-1
N_EXPERT_GROUPS = 4
EXPERTS_PER_GROUP = 4
N_EXPERTS = N_EXPERT_GROUPS * EXPERTS_PER_GROUP
TOP_K_INNER = 2
EXPERT_FF = D_MODEL // 2
RMS_EPS = 1e-6

Q_OFF = 0
K_OFF = Q_OFF + ATTN_WIDTH
V_OFF = K_OFF + ATTN_WIDTH
U_OFF = V_OFF + ATTN_WIDTH
GA_OFF = U_OFF + SSM_WIDTH
GB_OFF = GA_OFF + D_MODEL
IN_COLS = GB_OFF + D_MODEL

kernel_name = "hybrid_diffattn_s5_hmoe_encoder"


def rmsnorm(x, g):
    xf = x.astype(jnp.float32)
    y = xf * lax.rsqrt(jnp.mean(xf * xf, axis=-1, keepdims=True) + RMS_EPS)
    return (y * g.astype(jnp.float32)).astype(x.dtype)


def diff_attention(q, k, v, q_gain, k_gain, lam, slopes):
    B, S, H = q.shape[0], q.shape[1], q.shape[2]
    scale = ATTN_QK_DIM ** -0.5
    qf = rmsnorm(q, q_gain).astype(jnp.float32) * scale
    kf = rmsnorm(k, k_gain).astype(jnp.float32)
    vf = v.astype(jnp.float32)
    nb = S // Q_BLOCK
    qb = qf.reshape(B, nb, Q_BLOCK, H, 2, ATTN_QK_DIM).transpose(1, 0, 2, 3, 4, 5)
    kpos = jnp.arange(S, dtype=jnp.float32)

    def block(args):
        qi, i = args
        qpos = (i * Q_BLOCK + jnp.arange(Q_BLOCK)).astype(jnp.float32)
        dist = jnp.abs(qpos[:, None] - kpos[None, :])
        bias = -slopes[:, None, None, None] * dist[None, None]
        s = jnp.einsum('bqhcd,bkhcd->bhcqk', qi, kf) + bias
        p = jax.nn.softmax(s, axis=-1)
        w = p[:, :, 0] - lam * p[:, :, 1]
        return jnp.einsum('bhqk,bkhe->bqhe', w, vf)

    out = lax.map(block, (qb, jnp.arange(nb)))
    return out.transpose(1, 0, 2, 3, 4).reshape(B, S, H, ATTN_V_DIM)


def s5_direction(ug, lam_re, lam_im, log_dt, b_re, b_im, c_re, c_im, reverse):
    S = ug.shape[1]
    dt = jnp.exp(log_dt.astype(jnp.float32))[:, None]
    lr = lam_re.astype(jnp.float32)
    li = lam_im.astype(jnp.float32)
    mag = jnp.exp(lr * dt)
    a_re = mag * jnp.cos(li * dt)
    a_im = mag * jnp.sin(li * dt)
    nr = a_re - 1.0
    den = lr * lr + li * li
    f_re = (nr * lr + a_im * li) / den
    f_im = (a_im * lr - nr * li) / den
    br = b_re.astype(jnp.float32)
    bi = b_im.astype(jnp.float32)
    bb_re = f_re[..., None] * br - f_im[..., None] * bi
    bb_im = f_re[..., None] * bi + f_im[..., None] * br
    bu_re = jnp.einsum('gnp,bsgp->bsgn', bb_re, ug)
    bu_im = jnp.einsum('gnp,bsgp->bsgn', bb_im, ug)
    a_re_s = jnp.broadcast_to(a_re[None, None], (1, S) + a_re.shape)
    a_im_s = jnp.broadcast_to(a_im[None, None], (1, S) + a_im.shape)

    def combine(e1, e2):
        a1r, a1i, b1r, b1i = e1
        a2r, a2i, b2r, b2i = e2
        return (a1r * a2r - a1i * a2i,
                a1r * a2i + a1i * a2r,
                a2r * b1r - a2i * b1i + b2r,
                a2r * b1i + a2i * b1r + b2i)

    _, _, h_re, h_im = lax.associative_scan(
        combine, (a_re_s, a_im_s, bu_re, bu_im), reverse=reverse, axis=1)
    return (jnp.einsum('gpn,bsgn->bsgp', c_re.astype(jnp.float32), h_re)
            - jnp.einsum('gpn,bsgn->bsgp', c_im.astype(jnp.float32), h_im))


def s5_bidirectional(u, lam_re, lam_im, log_dt, b_re, b_im, c_re, c_im, d_skip, w_glu):
    B, S, W = u.shape
    ug = u.astype(jnp.float32).reshape(B, S, SSM_GROUPS, SSM_GROUP)
    y_f = s5_direction(ug, lam_re[0], lam_im[0], log_dt[0], b_re[0], b_im[0],
                       c_re[0], c_im[0], False)
    y_b = s5_direction(ug, lam_re[1], lam_im[1], log_dt[1], b_re[1], b_im[1],
                       c_re[1], c_im[1], True)
    d = d_skip.astype(jnp.float32).reshape(SSM_GROUPS, SSM_GROUP)
    y = (y_f + y_b + d * ug).reshape(B, S, W)
    y = jax.nn.gelu(y).astype(u.dtype)
    return y * jax.nn.sigmoid(y @ w_glu)


def hybrid_mixer(xn, layer_idx, slopes, w_in, q_gain, k_gain, lam_q1, lam_k1, lam_q2,
                 lam_k2, head_gain, w_attn_up, ssm_lam_re, ssm_lam_im, ssm_log_dt,
                 ssm_b_re, ssm_b_im, ssm_c_re, ssm_c_im, ssm_d, w_glu, w_ssm_up, w_out):
    B, S, _ = xn.shape
    h = xn @ w_in
    q = h[..., Q_OFF:K_OFF].reshape(B, S, ATTN_HEADS, 2, ATTN_QK_DIM)
    k = h[..., K_OFF:V_OFF].reshape(B, S, ATTN_HEADS, 2, ATTN_QK_DIM)
    v = h[..., V_OFF:U_OFF].reshape(B, S, ATTN_HEADS, ATTN_V_DIM)
    u = h[..., U_OFF:GA_OFF]
    g_a = h[..., GA_OFF:GB_OFF]
    g_b = h[..., GB_OFF:IN_COLS]

    lam_init = 0.8 - 0.6 * math.exp(-0.3 * layer_idx)
    f32 = jnp.float32
    lam = (jnp.exp(jnp.sum(lam_q1.astype(f32) * lam_k1.astype(f32)))
           - jnp.exp(jnp.sum(lam_q2.astype(f32) * lam_k2.astype(f32))) + lam_init)
    o = diff_attention(q, k, v, q_gain, k_gain, lam, slopes)
    o = rmsnorm(o, head_gain) * (1.0 - lam_init)
    a_out = o.reshape(B, S, ATTN_WIDTH).astype(xn.dtype) @ w_attn_up

    s_out = s5_bidirectional(u, ssm_lam_re, ssm_lam_im, ssm_log_dt, ssm_b_re, ssm_b_im,
                             ssm_c_re, ssm_c_im, ssm_d, w_glu)
    b_out = s_out @ w_ssm_up

    merged = jax.nn.sigmoid(g_a) * a_out + jax.nn.sigmoid(g_b) * b_out
    return merged @ w_out


def hier_moe(xn, w_rg, b_rg, w_re, b_re, w1, w3, w2):
    B, S, D = xn.shape
    t = xn.reshape(B * S, D)
    T = t.shape[0]
    tf = t.astype(jnp.float32)
    g_logits = tf @ w_rg.astype(jnp.float32) + b_rg.astype(jnp.float32)
    g_prob = jax.nn.softmax(g_logits, axis=-1)
    _, g_idx = lax.top_k(g_logits, 1)
    g_w = jnp.take_along_axis(g_prob, g_idx, axis=1)[:, 0]
    e_logits = (tf @ w_re.astype(jnp.float32) + b_re.astype(jnp.float32)).reshape(
        T, N_EXPERT_GROUPS, EXPERTS_PER_GROUP)
    sel = jnp.broadcast_to(g_idx[:, :, None], (T, 1, EXPERTS_PER_GROUP))
    e_in = jnp.take_along_axis(e_logits, sel, axis=1)[:, 0]
    top_v, top_i = lax.top_k(e_in, TOP_K_INNER)
    top_w = jax.nn.softmax(top_v, axis=-1) * g_w[:, None]
    eid = g_idx * EXPERTS_PER_GROUP + top_i
    combine = jnp.sum(jax.nn.one_hot(eid, N_EXPERTS, dtype=jnp.float32)
                      * top_w[..., None], axis=1)
    out = jnp.zeros((T, D), jnp.float32)
    for e in range(N_EXPERTS):
        hid = jax.nn.silu(t @ w1[e]) * (t @ w3[e])
        out = out + combine[:, e:e + 1] * (hid @ w2[e]).astype(jnp.float32)
    return out.reshape(B, S, D).astype(xn.dtype)


def setup_inputs(seed: int = 0) -> dict:
    key = jax.random.key(seed)
    ks = iter(jax.random.split(key, 40))
    L = DEPTH
    f32 = jnp.float32

    def nrm(shape, scale):
        return scale * jax.random.normal(next(ks), shape, f32)

    x = jax.random.normal(next(ks), (BATCH, SEQ, D_MODEL), f32)
    norm1 = 1.0 + nrm((L, D_MODEL), 0.02)
    w_in = nrm((L, D_MODEL, IN_COLS), D_MODEL ** -0.5)
    q_gain = 1.0 + nrm((L, ATTN_QK_DIM), 0.02)
    k_gain = 1.0 + nrm((L, ATTN_QK_DIM), 0.02)
    lam_q1 = nrm((L, ATTN_QK_DIM), 0.1)
    lam_k1 = nrm((L, ATTN_QK_DIM), 0.1)
    lam_q2 = nrm((L, ATTN_QK_DIM), 0.1)
    lam_k2 = nrm((L, ATTN_QK_DIM), 0.1)
    head_gain = 1.0 + nrm((L, ATTN_V_DIM), 0.02)
    w_attn_up = nrm((L, ATTN_WIDTH, D_MODEL), ATTN_WIDTH ** -0.5)
    n_idx = jnp.arange(SSM_STATE, dtype=f32)
    ssm_lam_re = -0.5 + nrm((L, 2, SSM_GROUPS, SSM_STATE), 0.01)
    ssm_lam_im = jnp.pi * n_idx + nrm((L, 2, SSM_GROUPS, SSM_STATE), 0.01)
    ssm_log_dt = jax.random.uniform(next(ks), (L, 2, SSM_GROUPS), f32,
                                    minval=math.log(DT_MIN), maxval=math.log(DT_MAX))
    b_scale = (2.0 * SSM_GROUP) ** -0.5
    c_scale = (2.0 * SSM_STATE) ** -0.5
    ssm_b_re = nrm((L, 2, SSM_GROUPS, SSM_STATE, SSM_GROUP), b_scale)
    ssm_b_im = nrm((L, 2, SSM_GROUPS, SSM_STATE, SSM_GROUP), b_scale)
    ssm_c_re = nrm((L, 2, SSM_GROUPS, SSM_GROUP, SSM_STATE), c_scale)
    ssm_c_im = nrm((L, 2, SSM_GROUPS, SSM_GROUP, SSM_STATE), c_scale)
    ssm_d = nrm((L, SSM_WIDTH), 1.0)
    w_glu = nrm((L, SSM_WIDTH, SSM_WIDTH), SSM_WIDTH ** -0.5)
    w_ssm_up = nrm((L, SSM_WIDTH, D_MODEL), SSM_WIDTH ** -0.5)
    w_out = nrm((L, D_MODEL, D_MODEL), D_MODEL ** -0.5)
    norm2 = 1.0 + nrm((L, D_MODEL), 0.02)
    w_router_group = nrm((L, D_MODEL, N_EXPERT_GROUPS), D_MODEL ** -0.5)
    b_router_group = nrm((L, N_EXPERT_GROUPS), 0.01)
    w_router_expert = nrm((L, D_MODEL, N_EXPERTS), D_MODEL ** -0.5)
    b_router_expert = nrm((L, N_EXPERTS), 0.01)
    w1 = nrm((L, N_EXPERTS, D_MODEL, EXPERT_FF), D_MODEL ** -0.5)
    w3 = nrm((L, N_EXPERTS, D_MODEL, EXPERT_FF), D_MODEL ** -0.5)
    w2 = nrm((L, N_EXPERTS, EXPERT_FF, D_MODEL), EXPERT_FF ** -0.5)
    return {"x": x, "norm1": norm1, "w_in": w_in, "q_gain": q_gain, "k_gain": k_gain,
            "lam_q1": lam_q1, "lam_k1": lam_k1, "lam_q2": lam_q2, "lam_k2": lam_k2,
            "head_gain": head_gain, "w_attn_up": w_attn_up, "ssm_lam_re": ssm_lam_re,
            "ssm_lam_im": ssm_lam_im, "ssm_log_dt": ssm_log_dt, "ssm_b_re": ssm_b_re,
            "ssm_b_im": ssm_b_im, "ssm_c_re": ssm_c_re, "ssm_c_im": ssm_c_im,
            "ssm_d": ssm_d, "w_glu": w_glu, "w_ssm_up": w_ssm_up, "w_out": w_out,
            "norm2": norm2, "w_router_group": w_router_group,
            "b_router_group": b_router_group, "w_router_expert": w_router_expert,
            "b_router_expert": b_router_expert, "w1": w1, "w3": w3, "w2": w2}


def reference(x, norm1, w_in, q_gain, k_gain, lam_q1, lam_k1, lam_q2, lam_k2, head_gain,
              w_attn_up, ssm_lam_re, ssm_lam_im, ssm_log_dt, ssm_b_re, ssm_b_im,
              ssm_c_re, ssm_c_im, ssm_d, w_glu, w_ssm_up, w_out, norm2,
              w_router_group, b_router_group, w_router_expert, b_router_expert,
              w1, w3, w2):
    slopes = jnp.exp2(-8.0 * jnp.arange(1, ATTN_HEADS + 1, dtype=jnp.float32) / ATTN_HEADS)
    for l in range(DEPTH):
        xn = rmsnorm(x, norm1[l])
        x = x + hybrid_mixer(xn, l, slopes, w_in[l], q_gain[l], k_gain[l], lam_q1[l],
                             lam_k1[l], lam_q2[l], lam_k2[l], head_gain[l], w_attn_up[l],
                             ssm_lam_re[l], ssm_lam_im[l], ssm_log_dt[l], ssm_b_re[l],
                             ssm_b_im[l], ssm_c_re[l], ssm_c_im[l], ssm_d[l], w_glu[l],
                             w_ssm_up[l], w_out[l])
        xn2 = rmsnorm(x, norm2[l])
        x = x + hier_moe(xn2, w_router_group[l], b_router_group[l], w_router_expert[l],
                         b_router_expert[l], w1[l], w3[l], w2[l])
    return x
```

```cpp
#include <hip/hip_runtime.h>
#include <cstdio>
#include <cstdint>

#ifndef MK_PER_PHASE
#define MK_PER_PHASE 0
#endif
#ifndef PH_MASK
#define PH_MASK 0x1fff
#endif

#define LAS __attribute__((address_space(3)))
#define GAS __attribute__((address_space(1)))
typedef unsigned short bf16_t;
typedef short bf16x8 __attribute__((ext_vector_type(8)));
typedef short s16x4 __attribute__((ext_vector_type(4)));
typedef float f32x2 __attribute__((ext_vector_type(2)));
typedef float f32x4 __attribute__((ext_vector_type(4)));
typedef float f32x16 __attribute__((ext_vector_type(16)));
typedef unsigned u32x2 __attribute__((ext_vector_type(2)));
typedef unsigned u32x4 __attribute__((ext_vector_type(4)));
typedef GAS unsigned gu32;
typedef int v4i_t __attribute__((ext_vector_type(4)));
typedef int v8i_t __attribute__((ext_vector_type(8)));

constexpr int NB = 8, SEQ = 4096, DM = 2048, DEPTH = 2;
constexpr int T = NB * SEQ;
constexpr int NH = 8, DQK = 64, DV = 128, AW = 1024;
constexpr int SW = 1024, SG = 16, NG = 64, SN = 64;
constexpr int CL = 32;
constexpr int NCH = SEQ / CL;
constexpr int RG = NB * NCH;
constexpr int KAUG = CL * SG + 4 * SN;
constexpr int NEXP = 16, FF = 1024;
constexpr int INC = 8192;
constexpr float EPS = 1e-6f;
constexpr float LOG2E = 1.4426950408889634f;
constexpr int MAXROWS = 2 * T + 32 * 256;
constexpr int MAXTILES = MAXROWS / 256;
constexpr float YSC = 16.0f;
constexpr float WSC = 32.0f;

constexpr size_t MiB = 1u << 20;
constexpr size_t WS_CTL = 0, CTL_ZERO_BYTES = 1 * MiB;
constexpr size_t WS_ROUTE = 1 * MiB;
constexpr size_t WS_ROWMAP = WS_ROUTE + (size_t)T * 16;
constexpr size_t WS_ROWW = WS_ROWMAP + (size_t)MAXROWS * 4;
constexpr size_t WS_TILES = WS_ROWW + (size_t)MAXROWS * 4;
constexpr size_t WS_WRB = WS_TILES + 4096;
static_assert(WS_WRB + 8 * 8 * 4 * 64 * 16 <= 4 * MiB, "small tables");
constexpr size_t WS_WIN = 4 * MiB;
constexpr size_t WS_WG8 = 20 * MiB;
constexpr size_t WS_WAUP = 36 * MiB;
constexpr size_t WS_WGLU = 40 * MiB;
constexpr size_t WS_WSUP = 42 * MiB;
constexpr size_t WS_WOUT = 46 * MiB;
constexpr size_t WS_W13 = 54 * MiB;
constexpr size_t WS_W2 = 182 * MiB;
constexpr size_t WS_TM = 246 * MiB;
constexpr size_t WS_WST = 294 * MiB;
constexpr size_t WS_XN = 310 * MiB;
constexpr size_t WS_Q = 438 * MiB;
constexpr size_t WS_K = 502 * MiB;
constexpr size_t WS_V = 566 * MiB;
constexpr size_t WS_HID = 438 * MiB;
constexpr size_t WS_Y = 630 * MiB;
constexpr size_t WS_GA = 630 * MiB;
constexpr size_t WS_GB = 694 * MiB;
constexpr size_t WS_AUG = 886 * MiB;
constexpr size_t WS_HLOC = 982 * MiB;
constexpr size_t WS_O = WS_Q;
constexpr size_t WS_XB = 1014 * MiB;
constexpr size_t WS_XN8 = 1142 * MiB;
constexpr size_t WS_END = 1206 * MiB;
static_assert(WS_HID + (size_t)MAXROWS * FF * 2 <= WS_GA, "hid overlay");
constexpr int CW_TMO = 0;
constexpr int CW_BAR = 4096;
constexpr int CW_CNT = 16384;
constexpr int CW_CUR = 16384 + 256;

constexpr int NWAVES = 8;
constexpr int RING_BYTES = 131072;
constexpr int LDS_BYTES = 163840;
constexpr int MISC_OFF = LDS_BYTES - 1024;

#define LDS_WAIT() asm volatile("s_waitcnt lgkmcnt(0)" ::: "memory")
#define VM_WAIT() asm volatile("s_waitcnt vmcnt(0)" ::: "memory")
#define RLX_AGENT __ATOMIC_RELAXED, __HIP_MEMORY_SCOPE_AGENT

typedef __bf16 bf16x2_t __attribute__((ext_vector_type(2)));
__device__ __forceinline__ unsigned cvt_pk_bf16(float lo, float hi) { f32x2 v = {lo, hi}; bf16x2_t b = __builtin_convertvector(v, bf16x2_t); return __builtin_bit_cast(unsigned, b); }
__device__ __forceinline__ unsigned pack_fp8x4(float a, float b, float c, float d) { int w = 0; w = __builtin_amdgcn_cvt_pk_fp8_f32(a, b, w, false); w = __builtin_amdgcn_cvt_pk_fp8_f32(c, d, w, true); return (unsigned)w; }
__device__ __forceinline__ f32x4 unpack_fp8x4(unsigned w) { const f32x2 lo = __builtin_amdgcn_cvt_pk_f32_fp8((int)w, false), hi = __builtin_amdgcn_cvt_pk_f32_fp8((int)w, true); return (f32x4){lo.x, lo.y, hi.x, hi.y}; }
__device__ __forceinline__ f32x4 unpack_bf16x4(u32x2 w) { return (f32x4){__uint_as_float(w.x << 16), __uint_as_float(w.x & 0xffff0000u), __uint_as_float(w.y << 16), __uint_as_float(w.y & 0xffff0000u)}; }
__device__ __forceinline__ float bf_lo(unsigned w) { return __uint_as_float(w << 16); }
__device__ __forceinline__ float bf_hi(unsigned w) { return __uint_as_float(w & 0xffff0000u); }
__device__ __forceinline__ float fast_sigmoid(float x) { return __builtin_amdgcn_rcpf(1.0f + __builtin_amdgcn_exp2f(-x * LOG2E)); }
__device__ __forceinline__ float gelu_tanh(float x) {
    const float z = 0.7978845608028654f * (x + 0.044715f * x * x * x);
    return x * fast_sigmoid(2.0f * z);
}
__device__ __forceinline__ int lane_id() { int l; asm volatile("v_mbcnt_lo_u32_b32 %0, -1, 0\n\tv_mbcnt_hi_u32_b32 %0, -1, %0" : "=v"(l)); return l; }
template <int M> __device__ __forceinline__ float shx(float v) { static_assert(M >= 1 && M <= 16, "shx: 1..16"); return __builtin_bit_cast(float, __builtin_amdgcn_ds_swizzle(__builtin_bit_cast(int, v), (M << 10) | 0x1f)); }
__device__ __forceinline__ float half_sum(float v) { auto rr = __builtin_amdgcn_permlane32_swap(__float_as_uint(v), __float_as_uint(v), false, false); return __uint_as_float(rr[0]) + __uint_as_float(rr[1]); }
template <int CTRL> __device__ __forceinline__ float dpp_add(float v) { return v + __builtin_bit_cast(float, __builtin_amdgcn_update_dpp(0, __builtin_bit_cast(int, v), CTRL, 0xf, 0xf, true)); }
__device__ __forceinline__ float row_sum16(float v) { v = dpp_add<0xB1>(v); v = dpp_add<0x4E>(v); v = dpp_add<0x141>(v); v = dpp_add<0x140>(v); return v; }
__device__ __forceinline__ float sum32(float v) { v = row_sum16(v); v += shx<16>(v); return v; }
__device__ __forceinline__ float wave_sum(float v) { v = row_sum16(v);
    const int b = __builtin_bit_cast(int, v);
    return (__builtin_bit_cast(float, __builtin_amdgcn_readlane(b, 0)) + __builtin_bit_cast(float, __builtin_amdgcn_readlane(b, 16))) + (__builtin_bit_cast(float, __builtin_amdgcn_readlane(b, 32)) + __builtin_bit_cast(float, __builtin_amdgcn_readlane(b, 48))); }

namespace pg8 {
constexpr int BM = 256, BK = 64, HALF = 128, HTB = HALF * BK * 2, STAGE_BYTES = 8 * HTB, NXCD = 8, WGM = 8;
__host__ __device__ __forceinline__ int lds_byte(int r, int c) { const int st = (r >> 4) * 2 + (c >> 5), rr = r & 15, cc = c & 31, ob = rr * 64 + cc * 2; return st * 1024 + (ob ^ (((ob >> 9) & 1) << 5)); }
__host__ __device__ __forceinline__ void stage_rc(int b, int& R, int& C) { const int st = b / 1024, sb = b % 1024, swz = sb ^ (((sb >> 9) & 1) << 5); R = (st >> 1) * 16 + swz / 64; C = (st & 1) * 32 + (swz % 64) / 2; }
__host__ __device__ __forceinline__ int perm32(int rho) { const int n = rho >> 4, i = rho & 15; return 8 * (i >> 2) + 4 * n + (i & 3); }

struct Unit { int pm, pn, z; unsigned aoff; size_t boff; const int* rows; };
struct Gemm { const bf16_t* A; const bf16_t* Bt; int lda, ldb, K; };

struct DenseOrder {
    int nM, nN, nwg, G, c, lda, ldb;
    __device__ void init(int M, int N, int G_, int c_, int lda_, int ldb_) { nM = M / BM; nN = N / BM; nwg = nM * nN; G = G_; c = c_; lda = lda_; ldb = ldb_; }
    __device__ bool next(int i, Unit& u) const {
        const long L = (long)i * G + c; if (L >= nwg) return false;
        int wgid = (int)L; { const int q = nwg / NXCD, r = nwg % NXCD, xcd = wgid % NXCD, off = wgid / NXCD; wgid = (xcd < r ? xcd * (q + 1) : r * (q + 1) + (xcd - r) * q) + off; }
        const int nig = WGM * nN, gid = wgid / nig, fm = gid * WGM, gsz = (nM - fm) < WGM ? (nM - fm) : WGM;
        u.pm = fm + ((wgid % nig) % gsz); u.pn = (wgid % nig) / gsz; u.z = 0;
        u.aoff = (unsigned)u.pm * BM * lda * 2u; u.boff = (size_t)u.pn * BM * ldb * 2; u.rows = nullptr; return true;
    }
};
struct BatchOrder {
    int nM, nN, nz, G, c, lda, ldb, rowsA, rowsB;
    __device__ void init(int nM_, int nN_, int nz_, int G_, int c_, int lda_, int ldb_, int rowsA_, int rowsB_) { nM = nM_; nN = nN_; nz = nz_; G = G_; c = c_; lda = lda_; ldb = ldb_; rowsA = rowsA_; rowsB = rowsB_; }
    __device__ bool next(int i, Unit& u) const {
        const int L = i * G + c; if (L >= nM * nN * nz) return false;
        u.z = L / (nM * nN); const int r = L % (nM * nN); u.pm = r / nN; u.pn = r % nN;
        u.aoff = (unsigned)(u.z * rowsA + u.pm * BM) * (unsigned)lda * 2u; u.boff = (size_t)(u.z * rowsB + u.pn * BM) * ldb * 2; u.rows = nullptr; return true;
    }
};
struct ChainOrder {
    DenseOrder D; unsigned aoff0, aoff1; size_t boff0, boff1;
    __device__ bool next(int i, Unit& u) const { if (!D.next(i >> 1, u)) return false; u.z = i & 1; u.aoff += u.z ? aoff1 : aoff0; u.boff += u.z ? boff1 : boff0; return true; }
};
struct MoeOrder {
    const int* tiles; const int* rowmap; int t0, t1, nN, G, c, lda, ldb, rowsB; bool gather;
    const volatile LAS int* ltab = nullptr;
    __device__ bool next(int i, Unit& u) const {
        const int L = i * G + c; if (L >= (t1 - t0) * nN) return false;
        const int tl = t0 + L / nN; u.pn = L % nN; int list, row0;
        if (ltab) { list = __builtin_amdgcn_readfirstlane(ltab[2 * i]); row0 = __builtin_amdgcn_readfirstlane(ltab[2 * i + 1]); }
        else { list = __builtin_amdgcn_readfirstlane(tiles[2 * tl]); row0 = __builtin_amdgcn_readfirstlane(tiles[2 * tl + 1]); }
        u.pm = row0 >> 8; u.z = list; u.aoff = (unsigned)row0 * (unsigned)lda * 2u; u.boff = (size_t)((list & 15) * rowsB + u.pn * BM) * ldb * 2; u.rows = gather ? rowmap + row0 : nullptr; return true;
    }
};

#ifndef PG8_ALIGN_EPI
#define PG8_ALIGN_EPI true
#endif
template <class Epi, class Sched, bool GATHER, bool FP8 = false, bool ALIGN_EPI = PG8_ALIGN_EPI>
__device__ __forceinline__ void gemm_phase(LAS unsigned char* lds, const Gemm g, const Sched& S, const Epi& E, int wave_id) {
    const int lane = lane_id(), wid = wave_id, tid = wid * 64 + lane,
              wr = wid >> 2, wc = wid & 3, fr = lane & 15, fq = lane >> 4;
    int K_ = g.K; asm volatile("" : "+s"(K_));
    const int K = K_, nt = K / BK;
    unsigned voffA[2], voffB[2];
#pragma unroll
    for (int i = 0; i < 2; ++i) { int R, C; stage_rc(tid * 16 + i * 8192, R, C); const int Rb = Epi::PERM ? ((R & ~31) + perm32(R & 31)) : R;
        voffA[i] = (unsigned)(R * g.lda + C) * 2u; voffB[i] = (unsigned)(Rb * g.ldb + C) * 2u; }
    const size_t kstep = (size_t)(BK * 2);
    const unsigned hstepA = (unsigned)HALF * (unsigned)g.lda * 2u;
    const size_t hstepB = (size_t)HALF * g.ldb * 2;
    const unsigned ldsw = (unsigned)wid * 1024u;
    const int aoff = lds_byte(wr * 64 + fr, fq * 8), boff = lds_byte(wc * 32 + fr, fq * 8);
#define PG8_SA(b, h) (((b) * 2 + (h)) * HTB)
#define PG8_SB(b, h) ((4 + (b) * 2 + (h)) * HTB)
#define PG8_STAGEB(bufoff, gbase) do { const char* _ub = (const char*)(gbase); asm volatile("" : "+s"(_ub)); _Pragma("unroll") for (int _i = 0; _i < 2; ++_i) \
        __builtin_amdgcn_global_load_lds((const unsigned*)(_ub + voffB[_i]), (LAS unsigned*)(lds + (bufoff) + ldsw + _i * 8192), 16, 0, 0); } while (0)
#define PG8_STAGEA(bufoff, ub, ug, offs, h) do { const char* _ua = GATHER ? (const char*)(ug) : (const char*)(ub) + (size_t)(h) * hstepA; asm volatile("" : "+s"(_ua)); _Pragma("unroll") for (int _i = 0; _i < 2; ++_i) { \
        if constexpr (GATHER) __builtin_amdgcn_global_load_lds((const unsigned*)(_ua + (offs)[h][_i]), (LAS unsigned*)(lds + (bufoff) + ldsw + _i * 8192), 16, 0, 0); \
        else __builtin_amdgcn_global_load_lds((const unsigned*)(_ua + voffA[_i]), (LAS unsigned*)(lds + (bufoff) + ldsw + _i * 8192), 16, 0, 0); } } while (0)
#define PG8_LD2(p) __builtin_shufflevector(*(const LAS v4i_t*)(p), *(const LAS v4i_t*)((p) + 1024), 0, 1, 2, 3, 4, 5, 6, 7)
#define PG8_LDA(dst, b, h) do { _Pragma("unroll") for (int m = 0; m < 4; ++m) dst[m] = PG8_LD2(lds + PG8_SA(b, h) + aoff + m * 2048); } while (0)
#define PG8_LDB(dst, b, h) do { _Pragma("unroll") for (int n = 0; n < 2; ++n) dst[n] = PG8_LD2(lds + PG8_SB(b, h) + boff + n * 2048); } while (0)
#define PG8_HALF(x, k) __builtin_bit_cast(bf16x8, __builtin_shufflevector(x, x, 4 * (k), 4 * (k) + 1, 4 * (k) + 2, 4 * (k) + 3))
#define PG8_MMA(ai, bj, At, Bt) do { __builtin_amdgcn_s_setprio(1); \
        if constexpr (FP8) { _Pragma("unroll") for (int m = 0; m < 4; ++m) _Pragma("unroll") for (int n = 0; n < 2; ++n) \
            acc[ai][bj][m][n] = __builtin_amdgcn_mfma_scale_f32_16x16x128_f8f6f4(Bt[n], At[m], acc[ai][bj][m][n], 0, 0, 0, 0x7f7f7f7f, 0, 0x7f7f7f7f); } \
        else { _Pragma("unroll") for (int m = 0; m < 4; ++m) _Pragma("unroll") for (int n = 0; n < 2; ++n) { \
            acc[ai][bj][m][n] = __builtin_amdgcn_mfma_f32_16x16x32_bf16(PG8_HALF(Bt[n], 0), PG8_HALF(At[m], 0), acc[ai][bj][m][n], 0, 0, 0); \
            acc[ai][bj][m][n] = __builtin_amdgcn_mfma_f32_16x16x32_bf16(PG8_HALF(Bt[n], 1), PG8_HALF(At[m], 1), acc[ai][bj][m][n], 0, 0, 0); } } \
        __builtin_amdgcn_s_setprio(0); } while (0)
#define PG8_WAIT_V(n) asm volatile("s_waitcnt vmcnt(" #n ")" ::: "memory")
#define PG8_WAIT_L(n) asm volatile("s_waitcnt lgkmcnt(" #n ")" ::: "memory")
#define PG8_BAR __builtin_amdgcn_s_barrier()
#define PG8_SCHED __builtin_amdgcn_sched_barrier(0)
#define PG8_UOFFS(dst, u) do { if constexpr (GATHER) { const int _t = wid * 64 + lane_id(); _Pragma("unroll") for (int _i = 0; _i < 2; ++_i) { int _R, _C; stage_rc(_t * 16 + _i * 8192, _R, _C); \
            _Pragma("unroll") for (int _h = 0; _h < 2; ++_h) { int _r = (u).rows[_h * HALF + _R]; _r = _r < 0 ? 0 : _r; dst[_h][_i] = (unsigned)_r * (unsigned)g.lda * 2u + (unsigned)_C * 2u; } } } } while (0)
    Unit cur, nxt; int ui = 0;
    if (!S.next(0, cur)) return;
    f32x4 acc[2][2][4][2];
#pragma unroll
    for (int a = 0; a < 2; ++a)
#pragma unroll
        for (int b = 0; b < 2; ++b)
#pragma unroll
            for (int m = 0; m < 4; ++m)
#pragma unroll
                for (int n = 0; n < 2; ++n) acc[a][b][m][n] = (f32x4){0.f, 0.f, 0.f, 0.f};
    v8i_t At[4], B0[2], B1[2];
    unsigned co[2][2], no[2][2];
    PG8_UOFFS(co, cur);
    const char* gA = (const char*)g.A;
    const char* cA = gA + cur.aoff;
    const char* cB = (const char*)g.Bt + cur.boff;
    PG8_STAGEB(PG8_SB(0, 0), cB); PG8_STAGEB(PG8_SB(0, 1), cB + hstepB); PG8_STAGEA(PG8_SA(0, 0), cA, gA, co, 0); PG8_STAGEA(PG8_SA(0, 1), cA, gA, co, 1);
    if (wr == 1) PG8_BAR;
    PG8_WAIT_V(2); PG8_BAR;
    PG8_STAGEB(PG8_SB(1, 0), cB + kstep); PG8_STAGEA(PG8_SA(1, 0), cA + kstep, gA + kstep, co, 0); PG8_STAGEB(PG8_SB(1, 1), cB + hstepB + kstep);
    PG8_WAIT_V(6); PG8_BAR;
    for (;;) {
        const bool has_next = S.next(ui + 1, nxt);
        const char* nA = has_next ? gA + nxt.aoff : cA; const char* nB = has_next ? (const char*)g.Bt + nxt.boff : cB;
#pragma unroll 1
        for (int t = 0; t < nt; t += 2) {
            const bool last = (t == nt - 2);
            asm volatile("" : "+v"(voffA[0]), "+v"(voffA[1]), "+v"(voffB[0]), "+v"(voffB[1]));
            const char* a1 = cA + (size_t)(t + 1) * kstep; const char* g1 = gA + (size_t)(t + 1) * kstep;
            const char* a2 = last ? nA : cA + (size_t)(t + 2) * kstep; const char* b2 = last ? nB : cB + (size_t)(t + 2) * kstep; const char* g2 = last ? gA : gA + (size_t)(t + 2) * kstep;
            const char* a3 = a2 + kstep; const char* b3 = b2 + kstep; const char* g3 = g2 + kstep;
            if constexpr (GATHER) { if (t == nt - 4) { if (has_next) { PG8_UOFFS(no, nxt); } else {
#pragma unroll
                for (int h = 0; h < 2; ++h)
#pragma unroll
                    for (int i = 0; i < 2; ++i) no[h][i] = co[h][i]; } } }
            PG8_LDB(B0, 0, 0); PG8_LDB(B1, 0, 1); PG8_SCHED; PG8_LDA(At, 0, 0); PG8_STAGEA(PG8_SA(1, 1), a1, g1, co, 1);
            if constexpr (GATHER) { if (last) {
#pragma unroll
                for (int h = 0; h < 2; ++h)
#pragma unroll
                    for (int i = 0; i < 2; ++i) co[h][i] = no[h][i]; } }
            PG8_WAIT_V(8); PG8_WAIT_L(0); PG8_BAR; PG8_MMA(0, 0, At, B0); PG8_MMA(0, 1, At, B1); PG8_BAR; PG8_SCHED;
            PG8_LDA(At, 0, 1); PG8_STAGEB(PG8_SB(0, 0), b2); PG8_STAGEB(PG8_SB(0, 1), b2 + hstepB); PG8_STAGEA(PG8_SA(0, 0), a2, g2, co, 0);
            PG8_WAIT_V(8); PG8_WAIT_L(0); PG8_BAR; PG8_MMA(1, 0, At, B0); PG8_MMA(1, 1, At, B1); PG8_BAR; PG8_SCHED;
            PG8_LDB(B0, 1, 0); PG8_LDB(B1, 1, 1); PG8_SCHED; PG8_LDA(At, 1, 0); PG8_STAGEA(PG8_SA(0, 1), a2, g2, co, 1);
            PG8_WAIT_V(8); PG8_WAIT_L(0); PG8_BAR; PG8_MMA(0, 0, At, B0); PG8_MMA(0, 1, At, B1); PG8_BAR; PG8_SCHED;
            PG8_LDA(At, 1, 1); PG8_STAGEB(PG8_SB(1, 0), b3); PG8_STAGEB(PG8_SB(1, 1), b3 + hstepB); PG8_STAGEA(PG8_SA(1, 0), a3, g3, co, 0);
            PG8_WAIT_V(8); PG8_WAIT_L(0); PG8_BAR; PG8_MMA(1, 0, At, B0); PG8_MMA(1, 1, At, B1); PG8_BAR; PG8_SCHED;
        }
        if constexpr (ALIGN_EPI) { if (wr == 0) PG8_BAR; }
        PG8_WAIT_V(0);
        { Unit eu = cur; eu.pm = __builtin_amdgcn_readfirstlane(eu.pm); eu.pn = __builtin_amdgcn_readfirstlane(eu.pn); eu.z = __builtin_amdgcn_readfirstlane(eu.z); asm volatile("" : "+s"(eu.pm), "+s"(eu.pn), "+s"(eu.z)); const int le = lane_id(), efr = le & 15, efq = le >> 4; bool keep = false;
          if constexpr (Epi::CHAIN) { if (eu.z == 0) { E.mid(acc, eu, wr, wc, efr, efq); keep = true; } else E(acc, eu, wr, wc, efr, efq); } else E(acc, eu, wr, wc, efr, efq);
          if (!has_next) break;
          if (!keep) {
#pragma unroll
            for (int a = 0; a < 2; ++a)
#pragma unroll
                for (int b = 0; b < 2; ++b)
#pragma unroll
                    for (int m = 0; m < 4; ++m)
#pragma unroll
                        for (int n = 0; n < 2; ++n) acc[a][b][m][n] = (f32x4){0.f, 0.f, 0.f, 0.f}; } }
        cur = nxt; cA = nA; cB = nB;
        ++ui;
        if constexpr (ALIGN_EPI) { if (wr == 1) PG8_BAR; }
    }
    PG8_WAIT_V(0);
    if constexpr (!ALIGN_EPI) { if (wr == 0) PG8_BAR; }
    PG8_BAR;
#undef PG8_SA
#undef PG8_SB
#undef PG8_STAGEA
#undef PG8_STAGEB
#undef PG8_LDA
#undef PG8_LDB
#undef PG8_MMA
#undef PG8_LD2
#undef PG8_HALF
#undef PG8_WAIT_V
#undef PG8_WAIT_L
#undef PG8_BAR
#undef PG8_SCHED
#undef PG8_UOFFS
}
}

using pg8::Unit;
__device__ __forceinline__ u32x4 pack8(const f32x4& a, const f32x4& b) { u32x4 w; w.x = cvt_pk_bf16(a[0], a[1]); w.y = cvt_pk_bf16(a[2], a[3]); w.z = cvt_pk_bf16(b[0], b[1]); w.w = cvt_pk_bf16(b[2], b[3]); return w; }
__device__ __forceinline__ void unpack8(const u32x4& w, f32x4& a, f32x4& b) { a = (f32x4){bf_lo(w.x), bf_hi(w.x), bf_lo(w.y), bf_hi(w.y)}; b = (f32x4){bf_lo(w.z), bf_hi(w.z), bf_lo(w.w), bf_hi(w.w)}; }

struct EpiIn {
    static constexpr bool PERM = true, CHAIN = false;
    unsigned char* ws;
    const float* qg; const float* kg;
    LAS float* xch; int wid;
    __device__ __forceinline__ void operator()(const f32x4 (&acc)[2][2][4][2], const Unit& u, int wr, int wc, int fr, int fq) const {
        const int row0 = u.pm * 256 + wr * 64 + fr, ct = u.pn, cl = wc * 32 + 8 * fq;
        if (ct < 8) {
            float ssq[2][4][2];
#pragma unroll
            for (int ai = 0; ai < 2; ++ai)
#pragma unroll
                for (int m = 0; m < 4; ++m)
#pragma unroll
                    for (int bj = 0; bj < 2; ++bj) { const f32x4 a = acc[ai][bj][m][0], b = acc[ai][bj][m][1]; float t = (a[0] * a[0] + a[1] * a[1]) + (a[2] * a[2] + a[3] * a[3]) + (b[0] * b[0] + b[1] * b[1]) + (b[2] * b[2] + b[3] * b[3]);
                        t += shx<16>(t); t = half_sum(t); ssq[ai][m][bj] = t;
                        if (fq == 0) xch[wid * 256 + ((ai * 4 + m) * 2 + bj) * 16 + fr] = t; }
            asm volatile("s_waitcnt lgkmcnt(0)" ::: "memory"); __builtin_amdgcn_s_barrier(); asm volatile("" ::: "memory");
            const bool isk = ct >= 4; const float* gp = (isk ? kg : qg) + (wc & 1) * 32 + 8 * fq; const float gs = isk ? 1.0f : 0.125f * LOG2E;
            const f32x4 g0 = *(const f32x4*)gp * gs, g1 = *(const f32x4*)(gp + 4) * gs;
            bf16_t* base = (bf16_t*)(ws + WS_Q + (size_t)(ct >> 2) * (WS_K - WS_Q)); const int c0 = (ct & 3) * 256 + cl;
#pragma unroll
            for (int ai = 0; ai < 2; ++ai)
#pragma unroll
                for (int m = 0; m < 4; ++m) { bf16_t* rp = base + (size_t)(row0 + ai * 128 + m * 16) * AW + c0;
#pragma unroll
                    for (int bj = 0; bj < 2; ++bj) { const float tot = ssq[ai][m][bj] + xch[(wid ^ 1) * 256 + ((ai * 4 + m) * 2 + bj) * 16 + fr]; const float rstd = 1.0f / sqrtf(tot * (1.0f / DQK) + EPS);
                        *(u32x4*)(rp + bj * 128) = pack8(acc[ai][bj][m][0] * g0 * rstd, acc[ai][bj][m][1] * g1 * rstd); } }
            asm volatile("s_waitcnt lgkmcnt(0)" ::: "memory"); __builtin_amdgcn_s_barrier(); asm volatile("" ::: "memory");
        } else {
            static_assert(WS_K - WS_Q == WS_V - WS_K && WS_GB > WS_GA, "EpiIn offset arithmetic");
            bf16_t* base = (bf16_t*)(ws + WS_Q + (size_t)(ct >> 2) * (WS_K - WS_Q)); const int c0 = (ct & 3) * 256 + cl;
#pragma unroll
            for (int ai = 0; ai < 2; ++ai)
#pragma unroll
                for (int m = 0; m < 4; ++m) { bf16_t* rp = base + (size_t)(row0 + ai * 128 + m * 16) * AW + c0;
#pragma unroll
                    for (int bj = 0; bj < 2; ++bj) *(u32x4*)(rp + bj * 128) = pack8(acc[ai][bj][m][0], acc[ai][bj][m][1]); }
        }
    }
};
struct EpiGate {
    static constexpr bool PERM = true, CHAIN = false;
    unsigned char* ws;
    __device__ __forceinline__ void operator()(const f32x4 (&acc)[2][2][4][2], const Unit& u, int wr, int wc, int fr, int fq) const {
        const int row0 = u.pm * 256 + wr * 64 + fr, cl = wc * 32 + 8 * fq; int ct = u.pn; constexpr float is = 1.0f / WSC;
        if (ct < 4) {
#pragma unroll
            for (int ai = 0; ai < 2; ++ai)
#pragma unroll
                for (int m = 0; m < 4; ++m) { const int tok = row0 + ai * 128 + m * 16;
#pragma unroll
                    for (int bj = 0; bj < 2; ++bj) { const int ch = ct * 256 + cl + bj * 128, gg = ch >> 4, p0 = ch & 15;
                        *(u32x4*)((bf16_t*)(ws + WS_AUG) + ((size_t)(gg * RG + (tok >> 5)) * KAUG + (tok & 31) * SG + p0)) = pack8(acc[ai][bj][m][0] * is, acc[ai][bj][m][1] * is); } }
            return; }
        ct -= 4;
        unsigned char* base = ws + WS_GA + (size_t)(ct >> 3) * (WS_GB - WS_GA); const int c0 = (ct & 7) * 256 + cl;
#pragma unroll
        for (int ai = 0; ai < 2; ++ai)
#pragma unroll
            for (int m = 0; m < 4; ++m) { unsigned char* rp = base + (size_t)(row0 + ai * 128 + m * 16) * DM + c0;
#pragma unroll
                for (int bj = 0; bj < 2; ++bj) { const f32x4 a = acc[ai][bj][m][0] * is, b = acc[ai][bj][m][1] * is; u32x2 w; w.x = 0u; w.y = 0u;
#pragma unroll
                    for (int j = 0; j < 4; ++j) { w.x = __builtin_amdgcn_cvt_pk_u8_f32(fast_sigmoid(a[j]) * 255.0f + 0.5f, j, w.x); w.y = __builtin_amdgcn_cvt_pk_u8_f32(fast_sigmoid(b[j]) * 255.0f + 0.5f, j, w.y); }
                    *(u32x2*)(rp + bj * 128) = w; } }
    }
};
struct EpiBf16Z {
    static constexpr bool PERM = true, CHAIN = false;
    bf16_t* O; int ldc; size_t zstride;
    __device__ __forceinline__ void operator()(const f32x4 (&acc)[2][2][4][2], const Unit& u, int wr, int wc, int fr, int fq) const {
        const int row0 = u.pm * 256 + wr * 64 + fr, c0 = u.pn * 256 + wc * 32 + 8 * fq; bf16_t* base = O + (size_t)u.z * zstride;
#pragma unroll
        for (int ai = 0; ai < 2; ++ai)
#pragma unroll
            for (int m = 0; m < 4; ++m) { bf16_t* rp = base + (size_t)(row0 + ai * 128 + m * 16) * ldc + c0;
#pragma unroll
                for (int bj = 0; bj < 2; ++bj) *(u32x4*)(rp + bj * 128) = pack8(acc[ai][bj][m][0], acc[ai][bj][m][1]); }
    }
};
struct EpiS5 {
    static constexpr bool PERM = true, CHAIN = false;
    const bf16_t* AUG; const float* dskip; bf16_t* Y;
    __device__ __forceinline__ void operator()(const f32x4 (&acc)[2][2][4][2], const Unit& u, int wr, int wc, int fr, int fq) const {
        const int row0 = u.pm * 256 + wr * 64 + fr, gg = u.z;
#pragma unroll
        for (int bj = 0; bj < 2; ++bj) { const int n0 = u.pn * 256 + bj * 128 + wc * 32 + 8 * fq, t = n0 >> 4, p0 = n0 & 15;
            const f32x4 d0 = *(const f32x4*)(dskip + gg * SG + p0), d1 = *(const f32x4*)(dskip + gg * SG + p0 + 4);
            u32x4 uw[2][4];
#pragma unroll
            for (int ai = 0; ai < 2; ++ai)
#pragma unroll
                for (int m = 0; m < 4; ++m) uw[ai][m] = *(const u32x4*)(AUG + ((size_t)(gg * RG + row0 + ai * 128 + m * 16) * KAUG + t * SG + p0));
            __builtin_amdgcn_sched_barrier(0);
#pragma unroll
            for (int ai = 0; ai < 2; ++ai)
#pragma unroll
                for (int m = 0; m < 4; ++m) { const int R = row0 + ai * 128 + m * 16; f32x4 ua, ub; unpack8(uw[ai][m], ua, ub);
                    f32x4 a = acc[ai][bj][m][0] + d0 * ua, b = acc[ai][bj][m][1] + d1 * ub;
#pragma unroll
                    for (int j = 0; j < 4; ++j) { a[j] = gelu_tanh(a[j]); b[j] = gelu_tanh(b[j]); }
                    *(u32x4*)(Y + ((size_t)(R * CL + t) * SW + gg * SG + p0)) = pack8(a, b); }
            __builtin_amdgcn_sched_barrier(0); }
    }
};
template <int MODE> struct EpiMul {
    static constexpr bool PERM = true, XU8 = MODE != 0, CHAIN = false;
    const void* Xv; bf16_t* O; int ldc;
    __device__ __forceinline__ void operator()(const f32x4 (&acc)[2][2][4][2], const Unit& u, int wr, int wc, int fr, int fq) const {
        const int row0 = u.pm * 256 + wr * 64 + fr, c0 = u.pn * 256 + wc * 32 + 8 * fq;
#pragma unroll
        for (int ai = 0; ai < 2; ++ai) {
            u32x4 xv[4][2], ov[4][2];
#pragma unroll
            for (int m = 0; m < 4; ++m)
#pragma unroll
                for (int bj = 0; bj < 2; ++bj) { const size_t ro = (size_t)(row0 + ai * 128 + m * 16) * ldc + c0 + bj * 128;
                    if (XU8) { const u32x2 t = *(const u32x2*)((const unsigned char*)Xv + ro); xv[m][bj].x = t.x; xv[m][bj].y = t.y; } else xv[m][bj] = *(const u32x4*)((const bf16_t*)Xv + ro);
                    if (MODE == 2) ov[m][bj] = *(const u32x4*)(O + ro); }
            __builtin_amdgcn_sched_barrier(0);
#pragma unroll
            for (int m = 0; m < 4; ++m)
#pragma unroll
                for (int bj = 0; bj < 2; ++bj) { const size_t ro = (size_t)(row0 + ai * 128 + m * 16) * ldc + c0 + bj * 128; f32x4 xa, xb;
                    if (XU8) { const unsigned w0 = xv[m][bj].x, w1 = xv[m][bj].y; constexpr float q = 1.0f / 255.0f;
                        xa = (f32x4){(float)(w0 & 0xffu), (float)((w0 >> 8) & 0xffu), (float)((w0 >> 16) & 0xffu), (float)(w0 >> 24)} * q; xb = (f32x4){(float)(w1 & 0xffu), (float)((w1 >> 8) & 0xffu), (float)((w1 >> 16) & 0xffu), (float)(w1 >> 24)} * q; }
                    else unpack8(xv[m][bj], xa, xb);
                    f32x4 a = acc[ai][bj][m][0], b = acc[ai][bj][m][1];
                    if (MODE == 0) {
#pragma unroll
                        for (int j = 0; j < 4; ++j) { a[j] = fast_sigmoid(a[j]); b[j] = fast_sigmoid(b[j]); } }
                    a = a * xa; b = b * xb;
                    if (MODE == 2) { f32x4 oa, ob; unpack8(ov[m][bj], oa, ob); a = a + oa; b = b + ob; }
                    *(u32x4*)(O + ro) = pack8(a, b); }
            __builtin_amdgcn_sched_barrier(0);
        }
    }
};
struct EpiUp {
    static constexpr bool PERM = true, CHAIN = true;
    const unsigned char* GA; const unsigned char* GB; bf16_t* O;
    static __device__ __forceinline__ void unq(const u32x2 t, f32x4& a, f32x4& b) { a = (f32x4){(float)(t.x & 0xffu), (float)((t.x >> 8) & 0xffu), (float)((t.x >> 16) & 0xffu), (float)(t.x >> 24)}; b = (f32x4){(float)(t.y & 0xffu), (float)((t.y >> 8) & 0xffu), (float)((t.y >> 16) & 0xffu), (float)(t.y >> 24)}; }
    __device__ __forceinline__ void mid(f32x4 (&acc)[2][2][4][2], const Unit& u, int wr, int wc, int fr, int fq) const {
        const int row0 = u.pm * 256 + wr * 64 + fr, c0 = u.pn * 256 + wc * 32 + 8 * fq;
#pragma unroll
        for (int ai = 0; ai < 2; ++ai) { u32x2 ga[4][2], gb[4][2];
#pragma unroll
            for (int m = 0; m < 4; ++m)
#pragma unroll
                for (int bj = 0; bj < 2; ++bj) { const size_t ro = (size_t)(row0 + ai * 128 + m * 16) * DM + c0 + bj * 128; ga[m][bj] = *(const u32x2*)(GA + ro); gb[m][bj] = *(const u32x2*)(GB + ro); }
            __builtin_amdgcn_sched_barrier(0);
#pragma unroll
            for (int m = 0; m < 4; ++m)
#pragma unroll
                for (int bj = 0; bj < 2; ++bj) { f32x4 a0, a1, b0, b1; unq(ga[m][bj], a0, a1); unq(gb[m][bj], b0, b1);
#pragma unroll
                    for (int j = 0; j < 4; ++j) { acc[ai][bj][m][0][j] *= a0[j] * __builtin_amdgcn_rcpf(fmaxf(b0[j], 0.5f)); acc[ai][bj][m][1][j] *= a1[j] * __builtin_amdgcn_rcpf(fmaxf(b1[j], 0.5f)); } }
            __builtin_amdgcn_sched_barrier(0); }
    }
    __device__ __forceinline__ void operator()(const f32x4 (&acc)[2][2][4][2], const Unit& u, int wr, int wc, int fr, int fq) const {
        const int row0 = u.pm * 256 + wr * 64 + fr, c0 = u.pn * 256 + wc * 32 + 8 * fq; constexpr float q = 1.0f / 255.0f;
#pragma unroll
        for (int ai = 0; ai < 2; ++ai) { u32x2 gb[4][2];
#pragma unroll
            for (int m = 0; m < 4; ++m)
#pragma unroll
                for (int bj = 0; bj < 2; ++bj) gb[m][bj] = *(const u32x2*)(GB + (size_t)(row0 + ai * 128 + m * 16) * DM + c0 + bj * 128);
            __builtin_amdgcn_sched_barrier(0);
#pragma unroll
            for (int m = 0; m < 4; ++m)
#pragma unroll
                for (int bj = 0; bj < 2; ++bj) { f32x4 b0, b1; unq(gb[m][bj], b0, b1);
#pragma unroll
                    for (int j = 0; j < 4; ++j) { b0[j] = fmaxf(b0[j], 0.5f) * q; b1[j] = fmaxf(b1[j], 0.5f) * q; }
                    *(u32x4*)(O + (size_t)(row0 + ai * 128 + m * 16) * DM + c0 + bj * 128) = pack8(acc[ai][bj][m][0] * b0, acc[ai][bj][m][1] * b1); }
            __builtin_amdgcn_sched_barrier(0); }
    }
};
struct EpiRes {
    static constexpr bool PERM = true, CHAIN = false;
    const float* base32; const bf16_t* base16; bf16_t* out;
    __device__ __forceinline__ void operator()(const f32x4 (&acc)[2][2][4][2], const Unit& u, int wr, int wc, int fr, int fq) const {
        const int row0 = u.pm * 256 + wr * 64 + fr, c0 = u.pn * 256 + wc * 32 + 8 * fq;
#pragma unroll
        for (int ai = 0; ai < 2; ++ai) {
            f32x4 ba[4][2], bb[4][2];
            if (base32) {
#pragma unroll
                for (int m = 0; m < 4; ++m)
#pragma unroll
                    for (int bj = 0; bj < 2; ++bj) { const float* p = base32 + (size_t)(row0 + ai * 128 + m * 16) * DM + c0 + bj * 128; ba[m][bj] = *(const f32x4*)p; bb[m][bj] = *(const f32x4*)(p + 4); }
            } else {
#pragma unroll
                for (int m = 0; m < 4; ++m)
#pragma unroll
                    for (int bj = 0; bj < 2; ++bj) unpack8(*(const u32x4*)(base16 + (size_t)(row0 + ai * 128 + m * 16) * DM + c0 + bj * 128), ba[m][bj], bb[m][bj]);
            }
            __builtin_amdgcn_sched_barrier(0);
#pragma unroll
            for (int m = 0; m < 4; ++m)
#pragma unroll
                for (int bj = 0; bj < 2; ++bj) *(u32x4*)(out + (size_t)(row0 + ai * 128 + m * 16) * DM + c0 + bj * 128) = pack8(ba[m][bj] + acc[ai][bj][m][0], bb[m][bj] + acc[ai][bj][m][1]);
            __builtin_amdgcn_sched_barrier(0);
        }
    }
};
struct EpiSwiglu {
    static constexpr bool PERM = true, CHAIN = false;
    unsigned char* HID;
    __device__ __forceinline__ void operator()(const f32x4 (&acc)[2][2][4][2], const Unit& u, int wr, int wc, int fr, int fq) const {
        const int row0 = u.pm * 256 + wr * 64 + fr, c0 = u.pn * 128 + wc * 32 + 8 * fq; constexpr float is = 1.0f / WSC;
#pragma unroll
        for (int ai = 0; ai < 2; ++ai)
#pragma unroll
            for (int m = 0; m < 4; ++m) { f32x4 a = acc[ai][0][m][0] * is, b = acc[ai][0][m][1] * is;
#pragma unroll
                for (int j = 0; j < 4; ++j) { a[j] = a[j] * fast_sigmoid(a[j]); b[j] = b[j] * fast_sigmoid(b[j]); }
                a = a * (acc[ai][1][m][0] * is); b = b * (acc[ai][1][m][1] * is);
                u32x2 w; w.x = pack_fp8x4(a[0], a[1], a[2], a[3]); w.y = pack_fp8x4(b[0], b[1], b[2], b[3]);
                *(u32x2*)(HID + (size_t)(row0 + ai * 128 + m * 16) * FF + c0) = w; }
    }
};
struct EpiY {
    static constexpr bool PERM = true, CHAIN = false;
    const int* rowmap; const float* roww; unsigned char* Y;
    __device__ __forceinline__ void operator()(const f32x4 (&acc)[2][2][4][2], const Unit& u, int wr, int wc, int fr, int fq) const {
        const int row0 = u.pm * 256 + wr * 64 + fr, c0 = u.pn * 256 + wc * 32 + 8 * fq; unsigned char* base = Y + (size_t)(u.z >> 4) * T * DM;
        int tok[2][4]; float w[2][4];
#pragma unroll
        for (int ai = 0; ai < 2; ++ai)
#pragma unroll
            for (int m = 0; m < 4; ++m) { const int pos = row0 + ai * 128 + m * 16; tok[ai][m] = rowmap[pos]; w[ai][m] = roww[pos] * (YSC / WSC); }
        __builtin_amdgcn_sched_barrier(0);
#pragma unroll
        for (int ai = 0; ai < 2; ++ai)
#pragma unroll
            for (int m = 0; m < 4; ++m) {
                if (tok[ai][m] >= 0) { unsigned char* rp = base + (size_t)tok[ai][m] * DM + c0;
#pragma unroll
                    for (int bj = 0; bj < 2; ++bj) { const f32x4 a = acc[ai][bj][m][0] * w[ai][m], b = acc[ai][bj][m][1] * w[ai][m]; u32x2 o; o.x = pack_fp8x4(a[0], a[1], a[2], a[3]); o.y = pack_fp8x4(b[0], b[1], b[2], b[3]);
                        *(u32x2*)(rp + bj * 128) = o; } } }
    }
};

#define XB_TMO      128
#define XB_XCNT(j)  (256  + 64 * (j))
#define XB_XSUB(j)  (1280 + 64 * (j))
#define XB_XGEN(j)  (2304 + 64 * (j))
#define XB_TOP      3328
#define XB_TOPGEN   3392
#define XCD_BAR_WORDS 3456
#define XB_SPIN_CAP (1u << 22)
__device__ __forceinline__ unsigned xb_ld(unsigned* p)              { return __hip_atomic_load(p, __ATOMIC_RELAXED, __HIP_MEMORY_SCOPE_AGENT); }
__device__ __forceinline__ unsigned xb_add(unsigned* p, unsigned v) { return __hip_atomic_fetch_add(p, v, __ATOMIC_RELAXED, __HIP_MEMORY_SCOPE_AGENT); }
__device__ __forceinline__ unsigned xb_xcc_id() { return (unsigned)__builtin_amdgcn_s_getreg((3 << 11) | 20) & 0xFu; }
#define XB_SPIN(cond, bar) do { unsigned _sp = 0; while (cond) { __builtin_amdgcn_s_sleep(1); \
    if ((++_sp & 255u) == 0u) { if (xb_ld(&(bar)[XB_TMO])) break; if (_sp > XB_SPIN_CAP) { atomicAdd(&(bar)[XB_TMO], 1u); break; } } } } while (0)
struct XcdBarrier { unsigned* bar; unsigned x; volatile LAS unsigned* st; };
__device__ __forceinline__ XcdBarrier xcd_barrier_post(unsigned* bar, volatile LAS unsigned* st) {
    XcdBarrier b; b.bar = bar; b.x = xb_xcc_id(); b.st = st;
    if (threadIdx.x == 0) (void)xb_add(&bar[XB_XCNT(b.x)], 1u);
    return b;
}
__device__ __forceinline__ void xcd_barrier_complete(unsigned* bar, unsigned x, unsigned& nloc, unsigned& nx) {
    const unsigned G = gridDim.x * gridDim.y * gridDim.z;
    unsigned sum, cnt, mine, sp = 0u;
    for (;;) {
        sum = 0u; cnt = 0u; mine = 0u;
#pragma unroll
        for (unsigned j = 0; j < 16; ++j) { const unsigned c = xb_ld(&bar[XB_XCNT(j)]); sum += c; cnt += (c > 0u) ? 1u : 0u; mine = (j == x) ? c : mine; }
        if (sum == G) break;
        __builtin_amdgcn_s_sleep(1);
        if ((++sp & 255u) == 0u) { if (xb_ld(&bar[XB_TMO])) break; if (sp > XB_SPIN_CAP) { atomicAdd(&bar[XB_TMO], 1u); break; } }
    }
    nloc = mine > 0u ? mine : 1u; nx = cnt > 0u ? cnt : 1u;
}
__device__ __forceinline__ void xcd_barrier(const XcdBarrier& b, bool leader) {
    asm volatile("s_waitcnt vmcnt(0)" ::: "memory");
    __syncthreads();
    if (leader) {
        unsigned* bar = b.bar;
        __builtin_amdgcn_s_waitcnt(0);
        unsigned nloc = b.st[0], nx = b.st[1];
        if (nloc == 0u) { xcd_barrier_complete(bar, b.x, nloc, nx); b.st[0] = nloc; b.st[1] = nx; }
        const unsigned old = xb_add(&bar[XB_XSUB(b.x)], 1u);
        const unsigned gen = old / nloc;
        if (old + 1u == (gen + 1u) * nloc) {
            __builtin_amdgcn_fence(__ATOMIC_RELEASE, "agent");
            asm volatile("s_waitcnt vmcnt(0)" ::: "memory");
            const unsigned og = xb_add(&bar[XB_TOP], 1u);
            const unsigned tg = og / nx;
            if (og + 1u == (tg + 1u) * nx) xb_add(&bar[XB_TOPGEN], 1u);
            else XB_SPIN(xb_ld(&bar[XB_TOPGEN]) == tg, bar);
            __builtin_amdgcn_fence(__ATOMIC_ACQUIRE, "agent");
            xb_add(&bar[XB_XGEN(b.x)], 1u);
            asm volatile("s_waitcnt vmcnt(0)" ::: "memory");
        } else {
            XB_SPIN(xb_ld(&bar[XB_XGEN(b.x)]) == gen, bar);
            __builtin_amdgcn_fence(__ATOMIC_ACQUIRE, "agent");
            asm volatile("s_waitcnt vmcnt(0)" ::: "memory");
        }
    }
    __syncthreads();
}

struct Args { const float* in[30]; float* out; unsigned char* ws; int ph_lo, ph_hi, pad0, pad1; };
struct Frame {
    LAS unsigned char* lds;
    int tid, lane, wave, vcu, G;
    const float* const* in;
    float* out; unsigned char* ws;
};
enum { IN_X = 0, IN_NORM1, IN_WIN, IN_QG, IN_KG, IN_LQ1, IN_LK1, IN_LQ2, IN_LK2, IN_HG, IN_WAUP, IN_LRE, IN_LIM, IN_LDT, IN_BRE, IN_BIM, IN_CRE, IN_CIM, IN_SD, IN_WGLU, IN_WSUP, IN_WOUT,
       IN_NORM2, IN_WRG, IN_BRG, IN_WRE, IN_BRE2, IN_W1, IN_W3, IN_W2 };

__device__ __forceinline__ const float* inp(const Frame& F, int i) { const volatile LAS unsigned* t = (const volatile LAS unsigned*)(F.lds + MISC_OFF + 256) + 2 * i;
    const unsigned lo = (unsigned)__builtin_amdgcn_readfirstlane((int)t[0]), hi = (unsigned)__builtin_amdgcn_readfirstlane((int)t[1]); return (const float*)(((unsigned long long)hi << 32) | lo); }

__device__ __forceinline__ void transpose_item_fp8(const float* W, int K, int N, unsigned char* WT, int orow0, LAS unsigned* scr, int k0, int n0, int lane, float sc) {
    const int n4 = (lane & 31) * 4, hk = lane >> 5;
#pragma unroll 1
    for (int part = 0; part < 4; ++part) {
        f32x4 a[4], b[4], c[4], d[4];
#pragma unroll
        for (int i = 0; i < 4; ++i) { const int kq = hk + 2 * (part * 4 + i); const float* p = W + (size_t)(k0 + 4 * kq) * N + n0 + n4; a[i] = *(const f32x4*)p; b[i] = *(const f32x4*)(p + N); c[i] = *(const f32x4*)(p + 2 * (size_t)N); d[i] = *(const f32x4*)(p + 3 * (size_t)N); }
#pragma unroll
        for (int i = 0; i < 4; ++i) { const int kq = hk + 2 * (part * 4 + i);
            scr[(n4 + 0) * 33 + kq] = pack_fp8x4(a[i].x * sc, b[i].x * sc, c[i].x * sc, d[i].x * sc); scr[(n4 + 1) * 33 + kq] = pack_fp8x4(a[i].y * sc, b[i].y * sc, c[i].y * sc, d[i].y * sc);
            scr[(n4 + 2) * 33 + kq] = pack_fp8x4(a[i].z * sc, b[i].z * sc, c[i].z * sc, d[i].z * sc); scr[(n4 + 3) * 33 + kq] = pack_fp8x4(a[i].w * sc, b[i].w * sc, c[i].w * sc, d[i].w * sc); }
    }
    LDS_WAIT(); asm volatile("" ::: "memory");
    const int cc = lane & 7;
#pragma unroll
    for (int j = 0; j < 16; ++j) { const int n = (lane >> 3) + 8 * j; const LAS unsigned* sp = scr + n * 33 + 4 * cc;
        u32x4 o; o.x = sp[0]; o.y = sp[1]; o.z = sp[2]; o.w = sp[3];
        *(u32x4*)(WT + (size_t)(orow0 + n) * K + k0 + 16 * cc) = o; }
    LDS_WAIT(); asm volatile("" ::: "memory");
}
__device__ __forceinline__ void transpose_item(const float* W, int K, int N, bf16_t* WT, int orow0, LAS unsigned* scr, int k0, int n0, int lane) {
    const int n4 = (lane & 31) * 4, hk = lane >> 5;
#pragma unroll
    for (int half = 0; half < 2; ++half) {
        f32x4 a[8], b[8];
#pragma unroll
        for (int i = 0; i < 8; ++i) { const int kp = hk + 2 * (half * 8 + i); const float* p = W + (size_t)(k0 + 2 * kp) * N + n0 + n4; a[i] = *(const f32x4*)p; b[i] = *(const f32x4*)(p + N); }
#pragma unroll
        for (int i = 0; i < 8; ++i) { const int kp = hk + 2 * (half * 8 + i);
            scr[(n4 + 0) * 33 + kp] = cvt_pk_bf16(a[i].x, b[i].x); scr[(n4 + 1) * 33 + kp] = cvt_pk_bf16(a[i].y, b[i].y); scr[(n4 + 2) * 33 + kp] = cvt_pk_bf16(a[i].z, b[i].z); scr[(n4 + 3) * 33 + kp] = cvt_pk_bf16(a[i].w, b[i].w); }
    }
    LDS_WAIT(); asm volatile("" ::: "memory");
    const int c = lane & 7;
#pragma unroll
    for (int j = 0; j < 16; ++j) { const int n = (lane >> 3) + 8 * j; const LAS unsigned* sp = scr + n * 33 + 4 * c;
        u32x4 o; o.x = sp[0]; o.y = sp[1]; o.z = sp[2]; o.w = sp[3];
        *(u32x4*)(WT + (size_t)(orow0 + n) * K + k0 + 8 * c) = o; }
    LDS_WAIT(); asm volatile("" ::: "memory");
}
__device__ __forceinline__ void cpow(float lr, float li, float dt, int k, float& re, float& im) {
    const float mag = __builtin_amdgcn_exp2f(lr * dt * (float)k * LOG2E);
    float x = li * dt * 0.15915494309189535f; x = x - floorf(x); float y = x * (float)k; y = y - floorf(y);
    re = mag * __builtin_amdgcn_cosf(y); im = mag * __builtin_amdgcn_sinf(y);
}
__device__ __forceinline__ void s5gen(Frame& F, int l, int g, int q) {
    LAS float* PW = (LAS float*)F.lds;
    LAS float* CC = PW + 2 * 33 * 64 * 2;
    LAS float* BB = CC + 2 * 16 * 64 * 2;
    LAS float* KD = BB + 2 * 64 * 16 * 2;
    const float* lre = inp(F, IN_LRE); const float* lim = inp(F, IN_LIM); const float* ldt = inp(F, IN_LDT);
    const float* bre = inp(F, IN_BRE); const float* bim = inp(F, IN_BIM); const float* cre = inp(F, IN_CRE); const float* cim = inp(F, IN_CIM);
    for (int e = F.tid; e < 2 * 33 * 64; e += 512) { const int dir = e / (33 * 64), d = (e / 64) % 33, n = e & 63; const int gi = (l * 2 + dir) * NG + g;
        const float dt = __builtin_amdgcn_exp2f(ldt[gi] * LOG2E); float re, im; cpow(lre[gi * SN + n], lim[gi * SN + n], dt, d, re, im); PW[e * 2] = re; PW[e * 2 + 1] = im; }
    for (int e = F.tid; e < 2 * 64 * 16; e += 512) { const int dir = e >> 10, n = (e >> 4) & 63, p = e & 15; const int gi = (l * 2 + dir) * NG + g;
        const float dt = __builtin_amdgcn_exp2f(ldt[gi] * LOG2E), lr = lre[gi * SN + n], li = lim[gi * SN + n]; float are, aim; cpow(lr, li, dt, 1, are, aim);
        const float nr = are - 1.0f, den = lr * lr + li * li, fre = (nr * lr + aim * li) / den, fim = (aim * lr - nr * li) / den;
        const float br = bre[(size_t)(gi * SN + n) * SG + p], bi = bim[(size_t)(gi * SN + n) * SG + p];
        BB[e * 2] = fre * br - fim * bi; BB[e * 2 + 1] = fre * bi + fim * br; }
    for (int e = F.tid; e < 2 * 16 * 64; e += 512) { const int dir = e >> 10, p = (e >> 6) & 15, n = e & 63; const int gi = (l * 2 + dir) * NG + g;
        CC[e * 2] = cre[(size_t)(gi * SG + p) * SN + n]; CC[e * 2 + 1] = cim[(size_t)(gi * SG + p) * SN + n]; }
    __syncthreads();
    { const int half = F.tid & 1, p = 4 * q + ((F.tid >> 1) & 3), d = (F.tid >> 3) & 31, dir = F.tid >> 8; float s8[8];
#pragma unroll
      for (int j = 0; j < 8; ++j) s8[j] = 0.f;
      const LAS f32x2* c = (const LAS f32x2*)(CC + (dir * 16 + p) * 128); const LAS f32x2* a = (const LAS f32x2*)(PW + (dir * 33 + d) * 128); const LAS f32x4* b = (const LAS f32x4*)(BB + dir * 2048 + half * 16);
#pragma unroll 4
      for (int n = 0; n < 64; ++n) { const f32x2 cv = c[n], av = a[n]; const float xr = cv.x * av.x - cv.y * av.y, xi = cv.x * av.y + cv.y * av.x;
          const f32x4 b0 = b[n * 8], b1 = b[n * 8 + 1], b2 = b[n * 8 + 2], b3 = b[n * 8 + 3];
          s8[0] += xr * b0.x - xi * b0.y; s8[1] += xr * b0.z - xi * b0.w; s8[2] += xr * b1.x - xi * b1.y; s8[3] += xr * b1.z - xi * b1.w;
          s8[4] += xr * b2.x - xi * b2.y; s8[5] += xr * b2.z - xi * b2.w; s8[6] += xr * b3.x - xi * b3.y; s8[7] += xr * b3.z - xi * b3.w; }
      LAS f32x4* kd = (LAS f32x4*)(KD + ((dir * 32 + d) * 16 + p) * 16 + half * 8);
      kd[0] = (f32x4){s8[0], s8[1], s8[2], s8[3]}; kd[1] = (f32x4){s8[4], s8[5], s8[6], s8[7]}; }
    __syncthreads();
    bf16_t* TMg = (bf16_t*)(F.ws + WS_TM) + (size_t)g * 512 * KAUG; bf16_t* WSg = (bf16_t*)(F.ws + WS_WST) + (size_t)g * 256 * 512;
    for (int e = F.tid; e < 128 * 64; e += 512) { const int t = e >> 8, p = 4 * q + ((e >> 6) & 3), row = t * 16 + p, ch = e & 63, s = ch >> 1, pp0 = (ch & 1) * 8; float v[8];
#pragma unroll
        for (int j = 0; j < 8; ++j) v[j] = t > s ? KD[((t - s) * 16 + p) * 16 + pp0 + j] : (t < s ? KD[8192 + ((s - t) * 16 + p) * 16 + pp0 + j] : KD[p * 16 + pp0 + j] + KD[8192 + p * 16 + pp0 + j]);
        u32x4 o; o.x = cvt_pk_bf16(v[0], v[1]); o.y = cvt_pk_bf16(v[2], v[3]); o.z = cvt_pk_bf16(v[4], v[5]); o.w = cvt_pk_bf16(v[6], v[7]);
        *(u32x4*)(TMg + (size_t)row * KAUG + s * 16 + pp0) = o; }
    for (int e = F.tid; e < 128 * 32; e += 512) { const int t = e >> 7, p = 4 * q + ((e >> 5) & 3), row = t * 16 + p, ch = e & 31, qt = ch >> 3, n0 = (ch & 7) * 8, dir = qt >> 1, d = dir == 0 ? t + 1 : 32 - t; float v[8];
#pragma unroll
        for (int j = 0; j < 8; ++j) { const int n = n0 + j; const float cr = CC[((dir * 16 + p) * 64 + n) * 2], ci = CC[((dir * 16 + p) * 64 + n) * 2 + 1], ar = PW[((dir * 33 + d) * 64 + n) * 2], ai = PW[((dir * 33 + d) * 64 + n) * 2 + 1];
            v[j] = (qt & 1) ? -(cr * ai + ci * ar) : (cr * ar - ci * ai); }
        u32x4 o; o.x = cvt_pk_bf16(v[0], v[1]); o.y = cvt_pk_bf16(v[2], v[3]); o.z = cvt_pk_bf16(v[4], v[5]); o.w = cvt_pk_bf16(v[6], v[7]);
        *(u32x4*)(TMg + (size_t)row * KAUG + 512 + qt * 64 + n0) = o; }
    for (int e = F.tid; e < 64 * 64; e += 512) { const int qt = e >> 10, n = 16 * q + ((e >> 6) & 15), r = qt * 64 + n, ch = e & 63, s = ch >> 1, pp0 = (ch & 1) * 8, dir = qt >> 1, d = dir == 0 ? 31 - s : s; float v[8];
        const float ar = PW[((dir * 33 + d) * 64 + n) * 2], ai = PW[((dir * 33 + d) * 64 + n) * 2 + 1];
#pragma unroll
        for (int j = 0; j < 8; ++j) { const float br = BB[((dir * 64 + n) * 16 + pp0 + j) * 2], bi = BB[((dir * 64 + n) * 16 + pp0 + j) * 2 + 1]; v[j] = (qt & 1) ? (ar * bi + ai * br) : (ar * br - ai * bi); }
        u32x4 o; o.x = cvt_pk_bf16(v[0], v[1]); o.y = cvt_pk_bf16(v[2], v[3]); o.z = cvt_pk_bf16(v[4], v[5]); o.w = cvt_pk_bf16(v[6], v[7]);
        *(u32x4*)(WSg + (size_t)r * 512 + s * 16 + pp0) = o; }
    __syncthreads();
}
__device__ __forceinline__ void ph_conv(Frame& F, int l) {
    for (int it = F.vcu; it < NG * 4; it += F.G) s5gen(F, l, it >> 2, it & 3);
    __syncthreads();
    { u32x4* wrb = (u32x4*)(F.ws + WS_WRB); const float* wrg = inp(F, IN_WRG) + (size_t)l * DM * 4; const float* wre = inp(F, IN_WRE) + (size_t)l * DM * 16; const float* g2 = inp(F, IN_NORM2) + (size_t)l * DM;
      for (int e = F.vcu * 512 + F.tid; e < 8 * 8 * 4 * 64; e += F.G * 512) { const int ln = e & 63, nb = (e >> 6) & 3, st = (e >> 8) & 7, w = e >> 11, n = ln & 15, q = ln >> 4;
          const int p = nb < 3 ? nb : (n >> 2), o = nb < 3 ? n : 16 + (n & 3), c0 = 256 * w + 32 * st + 8 * q; unsigned pk[4];
#pragma unroll
          for (int j2 = 0; j2 < 4; ++j2) { unsigned hb[2];
#pragma unroll
              for (int h = 0; h < 2; ++h) { const int c = c0 + 2 * j2 + h; const float f = p < 3 ? g2[c] * (o < 4 ? wrg[c * 4 + o] : wre[c * 16 + (o - 4)]) : 0.f;
                  const unsigned b0 = cvt_pk_bf16(f, 0.f) & 0xffffu; const float r1 = f - __uint_as_float(b0 << 16);
                  const unsigned b1 = cvt_pk_bf16(r1, 0.f) & 0xffffu; const float r2 = r1 - __uint_as_float(b1 << 16);
                  const unsigned b2 = cvt_pk_bf16(r2, 0.f) & 0xffffu; hb[h] = p == 0 ? b0 : (p == 1 ? b1 : b2); }
              pk[j2] = hb[0] | (hb[1] << 16); }
          wrb[e] = (u32x4){pk[0], pk[1], pk[2], pk[3]}; } }
    LAS unsigned* scr = (LAS unsigned*)(F.lds + F.wave * 17408);
    const int gw = F.vcu * NWAVES + F.wave, NGW = F.G * NWAVES;
    constexpr int I_IN = (DM / 64) * (3072 / 128), I_ING = (DM / 128) * (5120 / 128), I_AUP = (AW / 64) * (DM / 128), I_GLU = (SW / 64) * (SW / 128), I_SUP = (SW / 64) * (DM / 128), I_OUT = (DM / 64) * (DM / 128);
    constexpr int NITEMS = I_IN + I_ING + I_AUP + I_GLU + I_SUP + I_OUT;
    for (int it = gw; it < NITEMS; it += NGW) {
        int r = it;
        if (r < I_IN) { const int nblk = 3072 / 128; transpose_item(inp(F, IN_WIN) + (size_t)l * DM * INC, DM, INC, (bf16_t*)(F.ws + WS_WIN), 128 * (r % nblk), scr, 64 * (r / nblk), 128 * (r % nblk), F.lane); continue; } r -= I_IN;
        if (r < I_ING) { const int nblk = 5120 / 128; transpose_item_fp8(inp(F, IN_WIN) + (size_t)l * DM * INC, DM, INC, F.ws + WS_WG8, 128 * (r % nblk), scr, 128 * (r / nblk), 3072 + 128 * (r % nblk), F.lane, WSC); continue; } r -= I_ING;
        if (r < I_AUP) { const int nblk = DM / 128; transpose_item(inp(F, IN_WAUP) + (size_t)l * AW * DM, AW, DM, (bf16_t*)(F.ws + WS_WAUP), 128 * (r % nblk), scr, 64 * (r / nblk), 128 * (r % nblk), F.lane); continue; } r -= I_AUP;
        if (r < I_GLU) { const int nblk = SW / 128; transpose_item(inp(F, IN_WGLU) + (size_t)l * SW * SW, SW, SW, (bf16_t*)(F.ws + WS_WGLU), 128 * (r % nblk), scr, 64 * (r / nblk), 128 * (r % nblk), F.lane); continue; } r -= I_GLU;
        if (r < I_SUP) { const int nblk = DM / 128; transpose_item(inp(F, IN_WSUP) + (size_t)l * SW * DM, SW, DM, (bf16_t*)(F.ws + WS_WSUP), 128 * (r % nblk), scr, 64 * (r / nblk), 128 * (r % nblk), F.lane); continue; } r -= I_SUP;
        { const int nblk = DM / 128; transpose_item(inp(F, IN_WOUT) + (size_t)l * DM * DM, DM, DM, (bf16_t*)(F.ws + WS_WOUT), 128 * (r % nblk), scr, 64 * (r / nblk), 128 * (r % nblk), F.lane); }
    }
}
__device__ __forceinline__ void ph_conv_moe(Frame& F, int l) {
    const int lane = lane_id();
    LAS unsigned* scr = (LAS unsigned*)(F.lds + F.wave * 17408);
    int gw = F.vcu * NWAVES + F.wave; asm volatile("" : "+s"(gw)); const int NGW = F.G * NWAVES;
    constexpr int I_W1E = (DM / 128) * (FF / 128), I_W2E = (FF / 128) * (DM / 128);
    for (int it = gw; it < NEXP * (2 * I_W1E + I_W2E); it += NGW) {
        int r = it;
        const int e = r / (2 * I_W1E + I_W2E); r -= e * (2 * I_W1E + I_W2E);
        if (r < 2 * I_W1E) { const int w3 = r >= I_W1E; if (w3) r -= I_W1E; const int nblk = FF / 128, n0 = 128 * (r % nblk);
            transpose_item_fp8(inp(F, w3 ? IN_W3 : IN_W1) + ((size_t)l * NEXP + e) * DM * FF, DM, FF, F.ws + WS_W13 + (size_t)e * 2048 * DM, 2 * n0 + w3 * 128, scr, 128 * (r / nblk), n0, lane, WSC); continue; }
        r -= 2 * I_W1E;
        { const int nblk = DM / 128; transpose_item_fp8(inp(F, IN_W2) + ((size_t)l * NEXP + e) * FF * DM, FF, DM, F.ws + WS_W2 + (size_t)e * DM * FF, 128 * (r % nblk), scr, 128 * (r / nblk), 128 * (r % nblk), lane, WSC); }
    }
}
__device__ __forceinline__ void ph_norm1(Frame& F, int l, const float* xin, bool comb) {
    const int gw = F.vcu * NWAVES + F.wave, NGW = F.G * NWAVES; const float* gn = inp(F, IN_NORM1) + (size_t)l * DM; bf16_t* XN = (bf16_t*)(F.ws + WS_XN); const unsigned char* Y = F.ws + WS_Y; bf16_t* XB = (bf16_t*)(F.ws + WS_XB);
    LAS f32x4* gs = (LAS f32x4*)F.lds;
    __syncthreads(); gs[F.tid] = ((const f32x4*)gn)[F.tid]; __syncthreads();
    for (int m0 = gw; m0 < T; m0 += 2 * NGW) { f32x4 v[2][8];
        if (!comb) {
#pragma unroll
            for (int h = 0; h < 2; ++h) { const int m = m0 + h * NGW; if (m < T) { const f32x4* xr = (const f32x4*)(xin + (size_t)m * DM) + F.lane;
#pragma unroll
                for (int j = 0; j < 8; ++j) v[h][j] = xr[64 * j]; } }
        } else { u32x2 xv[2][8]; unsigned a[2][8], b[2][8];
#pragma unroll
            for (int h = 0; h < 2; ++h) { const int m = m0 + h * NGW; if (m < T) { const u32x2* xb = (const u32x2*)(XB + (size_t)m * DM) + F.lane; const unsigned* y0 = (const unsigned*)(Y + (size_t)m * DM) + F.lane; const unsigned* y1 = (const unsigned*)(Y + (size_t)(T + m) * DM) + F.lane;
#pragma unroll
                for (int j = 0; j < 8; ++j) { xv[h][j] = xb[64 * j]; a[h][j] = y0[64 * j]; b[h][j] = y1[64 * j]; } } }
            __builtin_amdgcn_sched_barrier(0);
#pragma unroll
            for (int h = 0; h < 2; ++h) { const int m = m0 + h * NGW; if (m < T) { u32x2* xb = (u32x2*)(XB + (size_t)m * DM) + F.lane;
#pragma unroll
                for (int j = 0; j < 8; ++j) { v[h][j] = unpack_bf16x4(xv[h][j]) + (unpack_fp8x4(a[h][j]) + unpack_fp8x4(b[h][j])) * (1.0f / YSC); u32x2 w; w.x = cvt_pk_bf16(v[h][j].x, v[h][j].y); w.y = cvt_pk_bf16(v[h][j].z, v[h][j].w); xb[64 * j] = w; v[h][j] = unpack_bf16x4(w); } } } }
        __builtin_amdgcn_sched_barrier(0);
#pragma unroll
        for (int h = 0; h < 2; ++h) { const int m = m0 + h * NGW; if (m < T) { float s = 0.f;
#pragma unroll
            for (int j = 0; j < 8; ++j) s += (v[h][j].x * v[h][j].x + v[h][j].y * v[h][j].y) + (v[h][j].z * v[h][j].z + v[h][j].w * v[h][j].w);
            const float rstd = 1.0f / sqrtf(wave_sum(s) * (1.0f / DM) + EPS);
            u32x2* o8 = (u32x2*)(XN + (size_t)m * DM) + F.lane;
            unsigned* o4 = (unsigned*)(F.ws + WS_XN8 + (size_t)m * DM) + F.lane;
#pragma unroll
            for (int j = 0; j < 8; ++j) { const f32x4 gv = gs[F.lane + 64 * j]; const f32x4 y = v[h][j] * rstd * gv; u32x2 w; w.x = cvt_pk_bf16(y.x, y.y); w.y = cvt_pk_bf16(y.z, y.w); o8[64 * j] = w; o4[64 * j] = pack_fp8x4(y.x, y.y, y.z, y.w); } } } }
}
__device__ __forceinline__ void ph_horner(Frame& F, int l) {
    const bf16_t* HL = (const bf16_t*)(F.ws + WS_HLOC); bf16_t* AUG = (bf16_t*)(F.ws + WS_AUG);
    for (int cid0 = F.vcu * 4; cid0 < NB * NG * 2; cid0 += F.G * 4) {
        __syncthreads();
        { u32x4 st[16];
#pragma unroll
          for (int i = 0; i < 16; ++i) { const int piece = F.tid + 512 * i, ch = piece >> 11, c = (piece >> 4) & 127, part = piece & 15, cid = cid0 + ch, dir = cid & 1, g = (cid >> 1) & 63, b = cid >> 7;
              st[i] = *(const u32x4*)(HL + ((size_t)g * RG + b * NCH + c) * 256 + dir * 128 + part * 8); }
#pragma unroll
          for (int i = 0; i < 16; ++i) { const int piece = F.tid + 512 * i; *(LAS u32x4*)(F.lds + piece * 16) = st[i]; } }
        __syncthreads();
        if (F.wave < 4) { const int cid = cid0 + F.wave, dir = cid & 1, g = (cid >> 1) & 63, b = cid >> 7, n = F.lane; const int gi = (l * 2 + dir) * NG + g;
            const float dt = __builtin_amdgcn_exp2f(inp(F, IN_LDT)[gi] * LOG2E); float are, aim; cpow(inp(F, IN_LRE)[gi * SN + n], inp(F, IN_LIM)[gi * SN + n], dt, CL, are, aim);
            float hr = 0.f, hi = 0.f; const size_t rbase = (size_t)g * RG + b * NCH; const LAS bf16_t* xs = (const LAS bf16_t*)(F.lds + F.wave * 32768) + n;
#pragma unroll 8
            for (int cc = 0; cc < NCH; ++cc) { const int c = dir == 0 ? cc : NCH - 1 - cc; bf16_t* ap = AUG + (rbase + c) * KAUG + 512 + dir * 128 + n;
                ap[0] = (bf16_t)(cvt_pk_bf16(hr, 0.f) & 0xffffu); ap[64] = (bf16_t)(cvt_pk_bf16(hi, 0.f) & 0xffffu);
                const float xr = __uint_as_float((unsigned)xs[c * 128] << 16), xi = __uint_as_float((unsigned)xs[c * 128 + 64] << 16);
                const float nr = are * hr - aim * hi + xr, ni = are * hi + aim * hr + xi; hr = nr; hi = ni; } }
    }
}

namespace attn {
constexpr int SHM_V = 64 * 128 * 2, SHM_K = 64 * 128 * 2, LDK = AW, HG_OFF = 139264;
#define KSWZ(row, colB) ((row) * 256 + ((colB) ^ (((row) & 7) << 4)))
__device__ __forceinline__ int crow(int r, int hi) { return (r & 3) + 8 * (r >> 2) + 4 * hi; }
__device__ __forceinline__ int v_rd_base(int lane) { return ((lane & 3) << 3) | (((lane >> 2) & 3) << 6) | (((lane >> 4) & 1) << 5) | (((lane >> 5) & 1) << 8); }
constexpr int v_rd_off(int d0, int ks, int half) { return d0 * 512 + ks * 4096 + half * 2048; }
template <int OFF> __device__ __forceinline__ s16x4 tr_read(int vb) { s16x4 r; asm volatile("ds_read_b64_tr_b16 %0, %1 offset:%2" : "=&v"(r) : "v"(vb), "i"(OFF) : "memory"); return r; }
template <int D0> __device__ __forceinline__ void pv_one(f32x16& od, int vb, bf16x8 pa0, bf16x8 pa1, bf16x8 pa2, bf16x8 pa3) {
    const s16x4 l0 = tr_read<v_rd_off(D0, 0, 0)>(vb), h0 = tr_read<v_rd_off(D0, 0, 1)>(vb), l1 = tr_read<v_rd_off(D0, 1, 0)>(vb), h1 = tr_read<v_rd_off(D0, 1, 1)>(vb);
    const s16x4 l2 = tr_read<v_rd_off(D0, 2, 0)>(vb), h2 = tr_read<v_rd_off(D0, 2, 1)>(vb), l3 = tr_read<v_rd_off(D0, 3, 0)>(vb), h3 = tr_read<v_rd_off(D0, 3, 1)>(vb);
    asm volatile("s_waitcnt lgkmcnt(0)" ::: "memory"); __builtin_amdgcn_sched_barrier(0);
#define PK(L, H) (bf16x8){L[0], L[1], L[2], L[3], H[0], H[1], H[2], H[3]}
    od = __builtin_amdgcn_mfma_f32_32x32x16_bf16(pa0, PK(l0, h0), od, 0, 0, 0);
    od = __builtin_amdgcn_mfma_f32_32x32x16_bf16(pa1, PK(l1, h1), od, 0, 0, 0);
    od = __builtin_amdgcn_mfma_f32_32x32x16_bf16(pa2, PK(l2, h2), od, 0, 0, 0);
    od = __builtin_amdgcn_mfma_f32_32x32x16_bf16(pa3, PK(l3, h3), od, 0, 0, 0);
#undef PK
    asm volatile("" : "+v"(od));
}
template <int MP> __device__ __forceinline__ void map_tile(f32x16 (&o)[4], float& lsum, const LAS char* qw, const LAS char* Ks, int vbuf, float dd, float nb) {
    const int ln = lane_id(), r32_ = ln & 31, hi_ = ln >> 5, kbase = r32_ * 256 + ((hi_ * 16) ^ ((r32_ & 7) << 4)), vb = vbuf + v_rd_base(ln); const LAS char* qs = qw + ln * 16;
    f32x16 p0, p1;
#pragma unroll
    for (int r = 0; r < 16; ++r) { p0[r] = 0.f; p1[r] = 0.f; }
    { const int kb = kbase + MP * 128, ksa = (int)(unsigned)(uintptr_t)Ks, qa = (int)(unsigned)(uintptr_t)qs + MP * 4096;
      bf16x8 kf0, kf1, qf;
#define QK_RK0(D0) do { const int ka_ = (kb ^ ((D0) << 5)) + ksa; asm volatile("ds_read_b128 %0, %1" : "=&v"(kf0) : "v"(ka_) : "memory"); } while (0)
#define QK_RK1(D0) do { const int ka_ = (kb ^ ((D0) << 5)) + ksa; asm volatile("ds_read_b128 %0, %1 offset:8192" : "=&v"(kf1) : "v"(ka_) : "memory"); } while (0)
#define QK_RQ(D0) asm volatile("ds_read_b128 %0, %1 offset:%2" : "=&v"(qf) : "v"(qa), "i"((D0) * 1024) : "memory")
#define QK_M0(WAITN) do { asm volatile("s_waitcnt lgkmcnt(" #WAITN ")" : "+v"(kf0), "+v"(qf) :: "memory"); p0 = __builtin_amdgcn_mfma_f32_32x32x16_bf16(kf0, qf, p0, 0, 0, 0); asm volatile("" : "+v"(p0)); } while (0)
#define QK_M1(WAITN) do { asm volatile("s_waitcnt lgkmcnt(" #WAITN ")" : "+v"(kf1), "+v"(qf) :: "memory"); p1 = __builtin_amdgcn_mfma_f32_32x32x16_bf16(kf1, qf, p1, 0, 0, 0); asm volatile("" : "+v"(p1)); } while (0)
      QK_RK0(0); QK_RQ(0); QK_RK1(0);
      QK_M0(1); QK_RK0(1); QK_M1(1); QK_RQ(1); QK_RK1(1);
      QK_M0(1); QK_RK0(2); QK_M1(1); QK_RQ(2); QK_RK1(2);
      QK_M0(1); QK_RK0(3); QK_M1(1); QK_RQ(3); QK_RK1(3);
      QK_M0(1); QK_M1(0);
#undef QK_RK0
#undef QK_RK1
#undef QK_RQ
#undef QK_M0
#undef QK_M1
    }
    asm volatile("" : "+v"(p0), "+v"(p1));
#pragma unroll
    for (int r = 0; r < 16; ++r) { const float cr = (float)((r & 3) + 8 * (r >> 2)); p0[r] = fmaf(fabsf(dd - cr), nb, p0[r]); p1[r] = fmaf(fabsf(dd - 32.0f - cr), nb, p1[r]); }
    float ps = 0.f;
#pragma unroll
    for (int r = 0; r < 16; ++r) { p0[r] = __builtin_amdgcn_exp2f(p0[r]); p1[r] = __builtin_amdgcn_exp2f(p1[r]); ps += p0[r] + p1[r]; }
    lsum += ps;
    bf16x8 pa0, pa1, pa2, pa3;
#define PK4(P, BASE, OUT) do { u32x4 w = {cvt_pk_bf16(P[BASE + 0], P[BASE + 1]), cvt_pk_bf16(P[BASE + 2], P[BASE + 3]), cvt_pk_bf16(P[BASE + 4], P[BASE + 5]), cvt_pk_bf16(P[BASE + 6], P[BASE + 7])}; \
    OUT = *reinterpret_cast<bf16x8*>(&w); } while (0)
    PK4(p0, 0, pa0); PK4(p0, 8, pa1); PK4(p1, 0, pa2); PK4(p1, 8, pa3);
#undef PK4
    __builtin_amdgcn_sched_barrier(0);
    s16x4 fl[4], fh[4];
#define PVK(L, H) (bf16x8){L[0], L[1], L[2], L[3], H[0], H[1], H[2], H[3]}
#define PV_READ(N) do { fl[(N) & 3] = tr_read<v_rd_off((N) & 3, ((N) >> 2) & 3, 0)>(vb); fh[(N) & 3] = tr_read<v_rd_off((N) & 3, ((N) >> 2) & 3, 1)>(vb); } while (0)
#define PV_STEP(N, PA, WAITN) do { \
    asm volatile("s_waitcnt lgkmcnt(" #WAITN ")" : "+v"(fl[(N) & 3]), "+v"(fh[(N) & 3]) :: "memory"); \
    o[(N) & 3] = __builtin_amdgcn_mfma_f32_32x32x16_bf16(PA, PVK(fl[(N) & 3], fh[(N) & 3]), o[(N) & 3], 0, 0, 0); \
    asm volatile("" : "+v"(o[(N) & 3])); \
    if ((N) + 4 < 16) PV_READ((N) + 4); } while (0)
    PV_READ(0); PV_READ(1); PV_READ(2); PV_READ(3);
    PV_STEP(0, pa0, 6); PV_STEP(1, pa0, 6); PV_STEP(2, pa0, 6); PV_STEP(3, pa0, 6);
    PV_STEP(4, pa1, 6); PV_STEP(5, pa1, 6); PV_STEP(6, pa1, 6); PV_STEP(7, pa1, 6);
    PV_STEP(8, pa2, 6); PV_STEP(9, pa2, 6); PV_STEP(10, pa2, 6); PV_STEP(11, pa2, 6);
    PV_STEP(12, pa3, 6); PV_STEP(13, pa3, 4); PV_STEP(14, pa3, 2); PV_STEP(15, pa3, 0);
#undef PV_STEP
#undef PV_READ
#undef PVK
}
__device__ __forceinline__ void stage_offs(unsigned (&ko)[2], unsigned (&vo)[2], int wid, int lane) {
#pragma unroll
    for (int i = 0; i < 2; ++i) { const int o = wid * 2048 + i * 1024 + lane * 16;
        { const int row = o >> 8, colB = (o & 255) ^ ((row & 7) << 4); ko[i] = (unsigned)(row * LDK * 2 + colB); }
        { const int sub = o >> 9, within = o & 511, kk = (sub >> 2) * 8 + (within >> 6), c = (sub & 3) * 32 + ((within & 63) >> 1);
          vo[i] = (unsigned)(kk * LDK * 2 + c * 2); } }
}
__device__ __forceinline__ void stage_kv(const char* Kt, const char* Vt, LAS char* Kd, LAS char* Vd, int wid) {
    unsigned ko[2], vo[2]; stage_offs(ko, vo, wid, lane_id());
    asm volatile("" : "+s"(Kt), "+s"(Vt));
#pragma unroll
    for (int i = 0; i < 2; ++i) {
        __builtin_amdgcn_global_load_lds((const unsigned*)(Kt + ko[i]), (LAS unsigned*)(Kd + wid * 2048 + i * 1024), 16, 0, 0);
        __builtin_amdgcn_global_load_lds((const unsigned*)(Vt + vo[i]), (LAS unsigned*)(Vd + wid * 2048 + i * 1024), 16, 0, 0); }
}
__device__ __forceinline__ void attn_unit(const bf16_t* Qb, const bf16_t* Kh, const bf16_t* Vh, bf16_t* Ob, int q0, int jlo, int jhi, float nb, const volatile LAS float* sbox, const float* hgain, LAS char* lds, int wave_id) {
    const int lane = lane_id(), wid = wave_id, tid = wid * 64 + lane, r32 = lane & 31, hi = lane >> 5;
    LAS char* V_lds = lds; LAS char* K_lds = lds + 2 * SHM_V; LAS float* wsf = (LAS float*)(lds + 2 * SHM_V + 2 * SHM_K) + wid * 128;
    LAS char* qw = lds + 2 * SHM_V + 2 * SHM_K + 4096 + wid * 8192; LAS char* qs = qw + lane * 16;
    stage_kv((const char*)(Kh + (size_t)jlo * 64 * LDK), (const char*)(Vh + (size_t)jlo * 64 * LDK), K_lds, V_lds, wid);
    { const bf16_t* Qw = Qb + (size_t)(wid * 32 + r32) * LDK + hi * 8; bf16x8 qv[8];
#pragma unroll
      for (int d0 = 0; d0 < 8; ++d0) qv[d0] = *(const bf16x8*)(Qw + d0 * 16);
#pragma unroll
      for (int d0 = 0; d0 < 8; ++d0) *(LAS bf16x8*)(qs + d0 * 1024) = qv[d0]; }
    f32x16 o1[4], o2[4];
#pragma unroll
    for (int d = 0; d < 4; ++d)
#pragma unroll
        for (int r = 0; r < 16; ++r) { o1[d][r] = 0.f; o2[d][r] = 0.f; }
    float l1 = 0.f, l2 = 0.f;
    const int vb0 = (int)(unsigned)(uintptr_t)V_lds;
    float dd = (float)(q0 + wid * 32 + r32 - 4 * hi - 64 * jlo);
    __syncthreads();
    for (int j = jlo; j < jhi; ++j) {
        const int b = (j - jlo) & 1;
        if (j + 1 < jhi) { size_t tb = (size_t)(j + 1) * 64 * LDK * 2; asm volatile("" : "+s"(tb));
            stage_kv((const char*)Kh + tb, (const char*)Vh + tb, K_lds + (b ^ 1) * SHM_K, V_lds + (b ^ 1) * SHM_V, wid); }
        __builtin_amdgcn_sched_barrier(0);
        map_tile<0>(o1, l1, qw, K_lds + b * SHM_K, vb0 + b * SHM_V, dd, nb);
        __builtin_amdgcn_sched_barrier(0);
        map_tile<1>(o2, l2, qw, K_lds + b * SHM_K, vb0 + b * SHM_V, dd, nb);
        __builtin_amdgcn_sched_barrier(0);
        dd -= 64.0f;
        __syncthreads();
    }
    const float lam = sbox[1], oscale = sbox[2];
    const int lane_e = lane_id(), r32e = lane_e & 31, hie = lane_e >> 5;
    l1 = half_sum(l1); l2 = half_sum(l2);
    if (hie == 0) { wsf[r32e] = l1; wsf[32 + r32e] = l2; }
    LDS_WAIT();
    float hg[4];
#pragma unroll
    for (int d = 0; d < 4; ++d) hg[d] = ((const LAS float*)(lds + HG_OFF))[d * 32 + r32e];
#pragma unroll
    for (int r = 0; r < 16; ++r) { const int row = crow(r, hie); const float a1 = __builtin_amdgcn_rcpf(wsf[row]), a2 = lam * __builtin_amdgcn_rcpf(wsf[32 + row]); float ss = 0.f;
#pragma unroll
        for (int d = 0; d < 4; ++d) { const float v = o1[d][r] * a1 - o2[d][r] * a2; o1[d][r] = v; ss += v * v; }
        ss = sum32(ss);
        const float rs = 1.0f / sqrtf(ss * (1.0f / DV) + EPS);
        bf16_t* op = Ob + (size_t)(wid * 32 + row) * LDK + r32e;
#pragma unroll
        for (int d = 0; d < 4; ++d) op[d * 32] = (bf16_t)(cvt_pk_bf16(o1[d][r] * rs * hg[d], 0.f) & 0xffffu); }
    __syncthreads();
}
}
__device__ __forceinline__ void ph_attn(Frame& F, int l) {
    const float lam_init = 0.8f - 0.6f * expf(-0.3f * (float)l);
    const float s1 = wave_sum(inp(F, IN_LQ1)[l * DQK + F.lane] * inp(F, IN_LK1)[l * DQK + F.lane]), s2 = wave_sum(inp(F, IN_LQ2)[l * DQK + F.lane] * inp(F, IN_LK2)[l * DQK + F.lane]);
    const float lam = expf(s1) - expf(s2) + lam_init;
    float gqm = fabsf(inp(F, IN_QG)[l * DQK + F.lane]), gkm = fabsf(inp(F, IN_KG)[l * DQK + F.lane]);
    gqm = fmaxf(gqm, shx<1>(gqm)); gqm = fmaxf(gqm, shx<2>(gqm)); gqm = fmaxf(gqm, shx<4>(gqm)); gqm = fmaxf(gqm, shx<8>(gqm)); gqm = fmaxf(gqm, shx<16>(gqm));
    gkm = fmaxf(gkm, shx<1>(gkm)); gkm = fmaxf(gkm, shx<2>(gkm)); gkm = fmaxf(gkm, shx<4>(gkm)); gkm = fmaxf(gkm, shx<8>(gkm)); gkm = fmaxf(gkm, shx<16>(gkm));
    { auto r1 = __builtin_amdgcn_permlane32_swap(__float_as_uint(gqm), __float_as_uint(gqm), false, false); gqm = fmaxf(__uint_as_float(r1[0]), __uint_as_float(r1[1]));
      auto r2 = __builtin_amdgcn_permlane32_swap(__float_as_uint(gkm), __float_as_uint(gkm), false, false); gkm = fmaxf(__uint_as_float(r2[0]), __uint_as_float(r2[1])); }
    const float thr = 2.0f * (8.0f * gqm * gkm * LOG2E) + 40.0f;
    const bf16_t* Q = (const bf16_t*)(F.ws + WS_Q); const bf16_t* Kb = (const bf16_t*)(F.ws + WS_K); const bf16_t* V = (const bf16_t*)(F.ws + WS_V); bf16_t* O = (bf16_t*)(F.ws + WS_O);
    const float* hgain = inp(F, IN_HG) + l * DV;
    volatile LAS float* sbox = (volatile LAS float*)(F.lds + MISC_OFF) + 24;
    if (F.tid == 0) { sbox[0] = thr; sbox[1] = lam; sbox[2] = 1.0f - lam_init; }
    if (F.tid < DV) ((LAS float*)(F.lds + attn::HG_OFF))[F.tid] = hgain[F.tid] * (1.0f - lam_init);
    __syncthreads();
    for (int rnd = 0; rnd * F.G < NB * NH * 16; ++rnd) { int h, b, qb;
        if (F.G == 256) {
            const int grp = F.vcu >> 7, w = F.vcu & 127, rank = grp == 0 ? (rnd == 0 ? 0 : rnd == 1 ? 2 : rnd == 2 ? 6 : 7) : (rnd == 0 ? 1 : rnd == 1 ? 3 : rnd == 2 ? 4 : 5);
            h = (NH - 1) - rank; b = w >> 4; qb = ((w & 15) + ((rnd & 1) << 3)) & 15;
        } else { const int pos = (rnd & 1) ? F.G - 1 - F.vcu : F.vcu, u = rnd * F.G + pos; if (u >= NB * NH * 16) continue;
            h = (NH - 1) - (u >> 7); b = (u >> 4) & 7; qb = u & 15; }
        const float slope = exp2f(-(float)(h + 1));
        const float dstar = sbox[0] / (slope * LOG2E); const int D = __builtin_amdgcn_readfirstlane(dstar >= (float)SEQ ? SEQ : (int)dstar);
        const int q0 = qb * 256; const int jlo = (q0 - D) <= 0 ? 0 : (q0 - D) >> 6; int jhi = ((q0 + 255 + D) >> 6) + 1; jhi = jhi > SEQ / 64 ? SEQ / 64 : jhi;
        const size_t rowb = (size_t)b * SEQ;
        attn::attn_unit(Q + (rowb + q0) * AW + h * DV, Kb + rowb * AW + h * DV, V + rowb * AW + h * DV, O + (rowb + q0) * AW + h * DV, q0, jlo, jhi, -slope * LOG2E, sbox, hgain, (LAS char*)F.lds, F.wave);
        if (rnd == (F.vcu & 3)) { ph_conv_moe(F, l); __syncthreads(); } }
}

constexpr int R_PITCH = 4096 + 32;
constexpr int R_BUF = 16 * R_PITCH;
constexpr int R_RED = 2 * R_BUF;
constexpr int R_SC = R_RED + 8 * 2112;
constexpr int R_RS = R_SC + 2048;
constexpr int R_CNT = R_RS + 64;
static_assert(R_CNT + 128 <= MISC_OFF, "router LDS map");
__device__ __forceinline__ void r_stage(const bf16_t* XB, int blk, LAS unsigned char* buf, int wave, int lane) {
    const char* src = (const char*)(XB + (size_t)blk * 16 * DM);
    asm volatile("" : "+s"(src));
#pragma unroll
    for (int i = 0; i < 8; ++i) { const int c = wave * 8 + i, row = c >> 2, qt = c & 3;
        __builtin_amdgcn_global_load_lds((const unsigned*)(src + row * 4096 + qt * 1024 + lane * 16), (LAS unsigned*)(buf + row * R_PITCH + qt * 1024), 16, 0, 0); }
}
__device__ __forceinline__ void ph_norm2_route(Frame& F, int l, bool count = true) {
    LAS unsigned char* L = (LAS unsigned char*)F.lds; LAS unsigned* lcnt = (LAS unsigned*)(L + R_CNT); LAS float* sc = (LAS float*)(L + R_SC); LAS float* rs = (LAS float*)(L + R_RS);
    if (F.tid < 32) lcnt[F.tid] = 0u;
    const int lane = F.lane, w = F.wave, n16 = lane & 15, q = lane >> 4;
    bf16x8 Bf[8][4];
    { const bf16x8* wb = (const bf16x8*)(F.ws + WS_WRB) + (size_t)w * 32 * 64 + lane;
#pragma unroll
      for (int st = 0; st < 8; ++st)
#pragma unroll
          for (int nb = 0; nb < 4; ++nb) Bf[st][nb] = wb[(st * 4 + nb) * 64]; }
    const f32x4 gv = *(const f32x4*)(inp(F, IN_NORM2) + (size_t)l * DM + 256 * w + 4 * lane);
    const bf16_t* XB = (const bf16_t*)(F.ws + WS_XB); unsigned char* X8 = F.ws + WS_XN;
    const float* brg = inp(F, IN_BRG) + l * 4; const float* bre = inp(F, IN_BRE2) + l * 16;
    constexpr int NBLK = T / 16;
    int blk = F.vcu;
    if (blk < NBLK) r_stage(XB, blk, L, w, lane);
    for (int it = 0; blk < NBLK; blk += F.G, ++it) {
        LAS unsigned char* buf = L + (it & 1) * R_BUF;
        VM_WAIT(); __syncthreads();
        if (blk + F.G < NBLK) r_stage(XB, blk + F.G, L + ((it + 1) & 1) * R_BUF, w, lane);
        float zr = 0.f; asm volatile("" : "+v"(zr));
        f32x4 a0 = {zr, zr, zr, zr}, a1 = a0, a2 = a0, a3 = a0, aS = a0;
        const LAS unsigned char* ap = buf + n16 * R_PITCH + (256 * w + 8 * q) * 2;
#pragma unroll
        for (int st = 0; st < 8; ++st) { const bf16x8 A = *(const LAS bf16x8*)(ap + st * 64);
            a0 = __builtin_amdgcn_mfma_f32_16x16x32_bf16(A, Bf[st][0], a0, 0, 0, 0); a1 = __builtin_amdgcn_mfma_f32_16x16x32_bf16(A, Bf[st][1], a1, 0, 0, 0);
            a2 = __builtin_amdgcn_mfma_f32_16x16x32_bf16(A, Bf[st][2], a2, 0, 0, 0); a3 = __builtin_amdgcn_mfma_f32_16x16x32_bf16(A, Bf[st][3], a3, 0, 0, 0);
            aS = __builtin_amdgcn_mfma_f32_16x16x32_bf16(A, A, aS, 0, 0, 0); }
        { LAS float* red = (LAS float*)(L + R_RED + w * 2112); const f32x4 as = (a0 + a1) + a2;
#pragma unroll
          for (int i = 0; i < 4; ++i) { red[i * 64 + lane] = as[i]; red[256 + i * 64 + lane] = a3[i]; }
          const int di = n16 & 3; const float dg = di == 0 ? aS[0] : (di == 1 ? aS[1] : (di == 2 ? aS[2] : aS[3]));
          if ((n16 >> 2) == q) red[512 + n16] = dg; }
        __syncthreads();
        { const int r = F.tid >> 5, n = F.tid & 31, ro = (r & 3) * 64 + 16 * (r >> 2); float ss = 0.f, lg = 0.f;
#pragma unroll
          for (int w2 = 0; w2 < 8; ++w2) { const LAS float* rw = (const LAS float*)(L + R_RED + w2 * 2112); ss += rw[512 + r];
              if (n < 16) lg += rw[ro + n]; else if (n < 20) lg += (rw[256 + ro + (n - 16)] + rw[256 + ro + 4 + (n - 16)]) + rw[256 + ro + 8 + (n - 16)]; }
          const float rstd = 1.0f / sqrtf(ss * (1.0f / DM) + EPS);
          sc[r * 32 + n] = lg * rstd; if (n == 0) rs[r] = rstd; }
        __syncthreads();
        { const LAS unsigned char* xp = buf + (256 * w + 4 * lane) * 2; unsigned char* op = X8 + (size_t)blk * 16 * DM + 256 * w + 4 * lane;
#pragma unroll
          for (int r = 0; r < 16; ++r) { const u32x2 xv = *(const LAS u32x2*)(xp + r * R_PITCH); const f32x4 y = unpack_bf16x4(xv) * rs[r] * gv;
              *(unsigned*)(op + (size_t)r * DM) = pack_fp8x4(y.x, y.y, y.z, y.w); } }
        if (F.tid < 16) { const LAS float* lg = sc + 32 * F.tid; float gl[4];
#pragma unroll
            for (int k = 0; k < 4; ++k) gl[k] = lg[k] + brg[k];
            int gi = 0; float gm = gl[0];
#pragma unroll
            for (int k = 1; k < 4; ++k) if (gl[k] > gm) { gm = gl[k]; gi = k; }
            float gs = 0.f;
#pragma unroll
            for (int k = 0; k < 4; ++k) gs += expf(gl[k] - gm);
            const float gwt = 1.0f / gs;
            float el[4];
#pragma unroll
            for (int k = 0; k < 4; ++k) el[k] = lg[4 + gi * 4 + k] + bre[gi * 4 + k];
            int i0 = 0; float v0 = el[0];
#pragma unroll
            for (int k = 1; k < 4; ++k) if (el[k] > v0) { v0 = el[k]; i0 = k; }
            int i1 = -1; float v1 = -3.0e38f;
#pragma unroll
            for (int k = 0; k < 4; ++k) if (k != i0 && el[k] > v1) { v1 = el[k]; i1 = k; }
            const float e1x = expf(v1 - v0), w0 = gwt / (1.0f + e1x), w1 = gwt * e1x / (1.0f + e1x);
            const int e0 = gi * 4 + i0, e1 = gi * 4 + i1;
            u32x4 rt; rt.x = (unsigned)e0; rt.y = (unsigned)e1; rt.z = __float_as_uint(w0); rt.w = __float_as_uint(w1);
            *(u32x4*)(F.ws + WS_ROUTE + (size_t)(blk * 16 + F.tid) * 16) = rt;
            if (count) { atomicAdd((unsigned*)&lcnt[e0], 1u); atomicAdd((unsigned*)&lcnt[16 + e1], 1u); } }
    }
    __syncthreads();
    if (F.tid < 32) { const unsigned c = lcnt[F.tid]; if (c) atomicAdd((unsigned*)(F.ws + WS_CTL) + CW_CNT + l * 32 + F.tid, c); }
    __syncthreads();
}
__device__ __forceinline__ void ph_route2(Frame& F, int l) {
    LAS int* lb = (LAS int*)F.lds;
    unsigned* ctl = (unsigned*)(F.ws + WS_CTL); int* tiles = (int*)(F.ws + WS_TILES); int* rowmap = (int*)(F.ws + WS_ROWMAP); float* roww = (float*)(F.ws + WS_ROWW);
    if (F.wave == 0) { const int ln = F.lane; const int c = ln < 32 ? (int)__hip_atomic_load(ctl + CW_CNT + l * 32 + ln, RLX_AGENT) : 0, pc = (c + 255) & ~255;
        if (ln < 32) lb[64 + ln] = pc;
        LDS_WAIT(); asm volatile("" ::: "memory");
        int base = 0;
#pragma unroll
        for (int j = 0; j < 32; ++j) { const int v = lb[64 + j]; base += j < ln ? v : 0; }
        if (ln < 32) { lb[ln] = base; lb[32 + ln] = c; }
        if (blockIdx.x == 0 && ln < 32) { for (int k = 0; k < pc; k += 256) { const int ti = (base + k) >> 8; tiles[2 * ti] = ln; tiles[2 * ti + 1] = base + k; }
            if (ln == 16) tiles[2 * MAXTILES + 1] = base >> 8;
            if (ln == 31) { tiles[2 * MAXTILES] = 0; tiles[2 * MAXTILES + 2] = (base + pc) >> 8; } } }
    __syncthreads();
    if (blockIdx.x == 0) { for (int i = 0; i < 32; ++i) { const int s = lb[i] + lb[32 + i], e = lb[i] + lb[64 + i]; for (int p = s + F.tid; p < e; p += 512) { rowmap[p] = -1; roww[p] = 0.f; } } }
    const int gw = F.vcu * NWAVES + F.wave, NGW = F.G * NWAVES;
    for (int ch = gw; ch < T / 64; ch += NGW) { const int t = ch * 64 + F.lane; const u32x4 rt = *(const u32x4*)(F.ws + WS_ROUTE + (size_t)t * 16); const unsigned long long lt = (1ull << F.lane) - 1ull;
#pragma unroll
        for (int s = 0; s < 2; ++s) { const int lid = (int)(s ? rt.y : rt.x); const float w = __uint_as_float(s ? rt.w : rt.z); int mycnt = 0, rank = 0;
#pragma unroll
            for (int L = 0; L < 16; ++L) { const unsigned long long m = __ballot(lid == L); if (F.lane == L) mycnt = __popcll(m); if (lid == L) rank = __popcll(m & lt); }
            unsigned old = 0u; if (F.lane < 16 && mycnt > 0) old = atomicAdd(ctl + CW_CUR + l * 32 + s * 16 + F.lane, (unsigned)mycnt);
            const int oldL = __builtin_amdgcn_ds_bpermute(lid << 2, (int)old);
            const int pos = lb[s * 16 + lid] + oldL + rank;
            rowmap[pos] = t; roww[pos] = w; } }
}

constexpr int PH_PER_LAYER = 13, N_PHASES = DEPTH * PH_PER_LAYER;
__device__ __forceinline__ const volatile LAS int* moe_tab(Frame& F, const int* tiles, int nt, int nN) {
    LAS int* lt = (LAS int*)(F.lds + MISC_OFF - 256);
    if ((nt * nN + F.G - 1) / F.G > 32) return nullptr;
    if (F.tid < 32) { const int L = F.tid * F.G + F.vcu; int a = 0, b = 0; if (L < nt * nN) { const int tl = L / nN; a = tiles[2 * tl]; b = tiles[2 * tl + 1]; } lt[2 * F.tid] = a; lt[2 * F.tid + 1] = b; }
    __syncthreads();
    return (const volatile LAS int*)lt;
}
__device__ __forceinline__ void moe_w2(Frame& F) {
    const int* tiles = (const int*)(F.ws + WS_TILES);
    pg8::Gemm g{(const bf16_t*)(F.ws + WS_HID), (const bf16_t*)(F.ws + WS_W2), FF / 2, FF / 2, FF / 2};
    const int nt = __builtin_amdgcn_readfirstlane(tiles[2 * MAXTILES + 2]);
    pg8::MoeOrder S{tiles, (const int*)(F.ws + WS_ROWMAP), 0, nt, DM / 256, F.G, F.vcu, FF / 2, FF / 2, DM, false, moe_tab(F, tiles, nt, DM / 256)};
    EpiY E{(const int*)(F.ws + WS_ROWMAP), (const float*)(F.ws + WS_ROWW), F.ws + WS_Y};
    pg8::gemm_phase<EpiY, pg8::MoeOrder, false, true>(F.lds, g, S, E, F.wave);
}
__device__ __forceinline__ void ph_combine(Frame& F) {
    const int gw = F.vcu * NWAVES + F.wave, NGW = F.G * NWAVES; const unsigned char* Y = F.ws + WS_Y; const bf16_t* XB = (const bf16_t*)(F.ws + WS_XB); constexpr float iy = 1.0f / YSC;
    for (int m = gw; m < T; m += NGW) { f32x4* xo = (f32x4*)(F.out + (size_t)m * DM) + F.lane; const u32x2* xb = (const u32x2*)(XB + (size_t)m * DM) + F.lane; const unsigned* y0 = (const unsigned*)(Y + (size_t)m * DM) + F.lane; const unsigned* y1 = (const unsigned*)(Y + (size_t)(T + m) * DM) + F.lane;
        u32x2 xv[8]; unsigned a[8], b[8];
#pragma unroll
        for (int j = 0; j < 8; ++j) { xv[j] = xb[64 * j]; a[j] = y0[64 * j]; b[j] = y1[64 * j]; }
#pragma unroll
        for (int j = 0; j < 8; ++j) xo[64 * j] = unpack_bf16x4(xv[j]) + (unpack_fp8x4(a[j]) + unpack_fp8x4(b[j])) * iy; }
}
__global__ void __launch_bounds__(NWAVES * 64, 2) fwd(Args args) {
    extern __shared__ __attribute__((aligned(16))) unsigned char lds_raw[];
    Frame F;
    F.lds = (LAS unsigned char*)lds_raw;
    F.tid = threadIdx.x; F.lane = F.tid & 63; F.wave = __builtin_amdgcn_readfirstlane(F.tid >> 6);
    F.G = gridDim.x; { const int bx = blockIdx.x; F.vcu = (F.G % 8 == 0) ? (bx % 8) * (F.G / 8) + bx / 8 : bx; }
    F.in = args.in; F.out = args.out; F.ws = args.ws;
    volatile LAS unsigned* MISC = (volatile LAS unsigned*)(F.lds + MISC_OFF);
    for (int u = F.tid; u < 256; u += NWAVES * 64) MISC[u] = 0u;
    __syncthreads();
    if (F.tid == 0) {
#pragma unroll
        for (int i = 0; i < 30; ++i) { const unsigned long long p = (unsigned long long)args.in[i]; MISC[64 + 2 * i] = (unsigned)p; MISC[65 + 2 * i] = (unsigned)(p >> 32); } }
    __syncthreads();
    XcdBarrier bar; bar.bar = (unsigned*)(F.ws + WS_CTL) + CW_BAR; bar.x = 0; bar.st = nullptr;
#if !MK_PER_PHASE
    bar = xcd_barrier_post((unsigned*)(F.ws + WS_CTL) + CW_BAR, MISC + 8);
#endif
#if MK_PER_PHASE
#define GRID_BAR() do { } while (0)
#else
#define GRID_BAR() xcd_barrier(bar, F.wave == 0 && lane_id() == 0)
#endif
#if MK_PER_PHASE
    const int lo = args.ph_lo, hi = args.ph_hi;
#else
    constexpr int lo = 0, hi = N_PHASES;
#endif
    for (int l = 0; l < DEPTH; ++l) {
        const int pb = l * PH_PER_LAYER;
#define IN(k) ((((PH_MASK) >> (k)) & 1) && lo <= pb + (k) && pb + (k) < hi)
#define FRESH() do { size_t z_ = 0; asm volatile("" : "+s"(z_)); F.ws = args.ws + z_; F.out = args.out + z_; F.lane = lane_id(); F.tid = F.wave * 64 + F.lane; } while (0)
#define ONCE() for (int once_ = 0; once_ < 1; ++once_)
#define SEAM(k) do { if (IN(k) && (pb + (k) + 1) < hi) GRID_BAR(); } while (0)
        if (IN(0)) ONCE() { FRESH();
#pragma unroll 1
            for (int step = 0; step < 2; ++step) { FRESH(); if ((step == 0) != ((F.vcu & 1) != 0)) ph_conv(F, l); else ph_norm1(F, l, inp(F, IN_X), l != 0); __syncthreads(); } }
        SEAM(0);
        if (IN(1)) ONCE() { FRESH();
            { pg8::Gemm g{(const bf16_t*)(F.ws + WS_XN), (const bf16_t*)(F.ws + WS_WIN), DM, DM, DM}; pg8::DenseOrder S; S.init(T, 3072, F.G, (int)blockIdx.x, DM, DM);
              EpiIn E{F.ws, inp(F, IN_QG) + l * DQK, inp(F, IN_KG) + l * DQK, (LAS float*)(F.lds + RING_BYTES), F.wave};
              pg8::gemm_phase<EpiIn, pg8::DenseOrder, false>(F.lds, g, S, E, F.wave); }
            FRESH();
            { pg8::Gemm g{(const bf16_t*)(F.ws + WS_XN8), (const bf16_t*)(F.ws + WS_WG8), DM / 2, DM / 2, DM / 2}; pg8::DenseOrder S; S.init(T, 5120, F.G, (int)blockIdx.x, DM / 2, DM / 2);
              EpiGate E{F.ws};
              pg8::gemm_phase<EpiGate, pg8::DenseOrder, false, true>(F.lds, g, S, E, F.wave); }
        }
        SEAM(1);
        if (IN(2)) ONCE() { FRESH();
            pg8::Gemm g{(const bf16_t*)(F.ws + WS_AUG), (const bf16_t*)(F.ws + WS_WST), KAUG, CL * SG, CL * SG}; pg8::BatchOrder S; S.init(RG / 256, 1, NG, F.G, F.vcu, KAUG, CL * SG, RG, 256);
            EpiBf16Z E{(bf16_t*)(F.ws + WS_HLOC), 256, (size_t)RG * 256};
            pg8::gemm_phase<EpiBf16Z, pg8::BatchOrder, false>(F.lds, g, S, E, F.wave);
        }
        SEAM(2);
        if (IN(3)) ONCE() { FRESH(); ph_horner(F, l); __syncthreads(); ph_attn(F, l); }
        SEAM(3);
        if (IN(4)) ONCE() { FRESH();
            pg8::Gemm g{(const bf16_t*)(F.ws + WS_AUG), (const bf16_t*)(F.ws + WS_TM), KAUG, KAUG, KAUG}; pg8::BatchOrder S; S.init(RG / 256, (CL * SG) / 256, NG, F.G, F.vcu, KAUG, KAUG, RG, CL * SG);
            EpiS5 E{(const bf16_t*)(F.ws + WS_AUG), inp(F, IN_SD) + (size_t)l * SW, (bf16_t*)(F.ws + WS_K)};
            pg8::gemm_phase<EpiS5, pg8::BatchOrder, false>(F.lds, g, S, E, F.wave);
        }
        SEAM(4);
        if (IN(5)) ONCE() { FRESH();
            pg8::Gemm g{(const bf16_t*)(F.ws + WS_K), (const bf16_t*)(F.ws + WS_WGLU), SW, SW, SW}; pg8::DenseOrder S; S.init(T, SW, F.G, (int)blockIdx.x, SW, SW);
            EpiMul<0> E{(const void*)(F.ws + WS_K), (bf16_t*)(F.ws + WS_V), SW};
            pg8::gemm_phase<EpiMul<0>, pg8::DenseOrder, false>(F.lds, g, S, E, F.wave);
        }
        SEAM(5);
        if (IN(6)) ONCE() { FRESH();
            static_assert(WS_V > WS_O && WS_WSUP > WS_WAUP, "chained UP operands: offsets relative to the lower buffer");
            { pg8::Gemm g{(const bf16_t*)(F.ws + WS_O), (const bf16_t*)(F.ws + WS_WAUP), AW, AW, AW};
              pg8::ChainOrder S; S.D.init(T, DM, F.G, (int)blockIdx.x, AW, AW); S.aoff0 = 0u; S.aoff1 = (unsigned)(WS_V - WS_O); S.boff0 = 0; S.boff1 = (size_t)(WS_WSUP - WS_WAUP);
              EpiUp E{F.ws + WS_GA, F.ws + WS_GB, (bf16_t*)(F.ws + WS_XN)};
              pg8::gemm_phase<EpiUp, pg8::ChainOrder, false>(F.lds, g, S, E, F.wave); }
        }
        SEAM(6);
        if (IN(7)) ONCE() { FRESH();
            pg8::Gemm g{(const bf16_t*)(F.ws + WS_XN), (const bf16_t*)(F.ws + WS_WOUT), DM, DM, DM}; pg8::DenseOrder S; S.init(T, DM, F.G, (int)blockIdx.x, DM, DM);
            EpiRes E{l == 0 ? inp(F, IN_X) : nullptr, (const bf16_t*)(F.ws + WS_XB), (bf16_t*)(F.ws + WS_XB)};
            pg8::gemm_phase<EpiRes, pg8::DenseOrder, false>(F.lds, g, S, E, F.wave);
        }
        SEAM(7);
        if (IN(8)) { FRESH(); ph_norm2_route(F, l); }
        SEAM(8);
        if (IN(9)) { FRESH(); ph_route2(F, l); }
        SEAM(9);
        if (IN(10)) ONCE() { FRESH();
            const int* tiles = (const int*)(F.ws + WS_TILES);
            pg8::Gemm g{(const bf16_t*)(F.ws + WS_XN), (const bf16_t*)(F.ws + WS_W13), DM / 2, DM / 2, DM / 2};
            const int nt = __builtin_amdgcn_readfirstlane(tiles[2 * MAXTILES + 2]);
            pg8::MoeOrder S{tiles, (const int*)(F.ws + WS_ROWMAP), 0, nt, (2 * FF) / 256, F.G, F.vcu, DM / 2, DM / 2, 2 * FF, true, moe_tab(F, tiles, nt, (2 * FF) / 256)};
            EpiSwiglu E{F.ws + WS_HID};
            pg8::gemm_phase<EpiSwiglu, pg8::MoeOrder, true, true>(F.lds, g, S, E, F.wave);
        }
        SEAM(10);
        if (IN(11)) ONCE() { FRESH(); moe_w2(F); }
        if (l + 1 < DEPTH) { SEAM(11); }
        else { if (IN(11) && IN(12)) GRID_BAR();
               if (IN(12)) { FRESH(); ph_combine(F); } }
#undef IN
#undef SEAM
    }
}


extern "C" void kernel_launch(void* const* d_in, const int* in_sizes, int n_in, void* d_out, int out_size, void* d_ws, size_t ws_size, hipStream_t stream) {
    static int grid = 0;
    if (grid == 0) {
        if (n_in != 30 || in_sizes[0] != T * DM || out_size != T * DM || ws_size < WS_END) { fprintf(stderr, "kernel_launch: shape mismatch (n_in %d, in0 %d, out %d, ws %zu < %zu)\n", n_in, n_in > 0 ? in_sizes[0] : -1, out_size, ws_size, (size_t)WS_END); grid = -1; return; }
        int dev = 0, cus = 0, per_cu = 0;
        if (hipGetDevice(&dev) != hipSuccess || hipDeviceGetAttribute(&cus, hipDeviceAttributeMultiprocessorCount, dev) != hipSuccess) { grid = -1; return; }
        if (hipFuncSetAttribute((const void*)fwd, hipFuncAttributeMaxDynamicSharedMemorySize, LDS_BYTES) != hipSuccess) { fprintf(stderr, "kernel_launch: hipFuncSetAttribute failed\n"); grid = -1; return; }
        if (hipOccupancyMaxActiveBlocksPerMultiprocessor(&per_cu, (const void*)fwd, NWAVES * 64, LDS_BYTES) != hipSuccess || per_cu < 1) fprintf(stderr, "kernel_launch: occupancy query says %d\n", per_cu);
        (void)hipGetLastError();
        grid = cus;
    }
    if (grid < 0) return;
    if (hipMemsetAsync((char*)d_ws + WS_CTL, 0, CTL_ZERO_BYTES, stream) != hipSuccess) return;
    Args a{};
    for (int i = 0; i < 30; ++i) a.in[i] = (const float*)d_in[i];
    a.out = (float*)d_out; a.ws = (unsigned char*)d_ws;
#if MK_PER_PHASE
#ifndef DBG_NPH
#define DBG_NPH N_PHASES
#endif
    for (int p = 0; p < DBG_NPH; ++p) { a.ph_lo = p; a.ph_hi = p + 1; hipLaunchKernelGGL(fwd, dim3(grid), dim3(NWAVES * 64), LDS_BYTES, stream, a); }
#else
    a.ph_lo = 0; a.ph_hi = N_PHASES; hipLaunchKernelGGL(fwd, dim3(grid), dim3(NWAVES * 64), LDS_BYTES, stream, a);
#endif
    const hipError_t le = hipPeekAtLastError();
    if (le != hipSuccess) fprintf(stderr, "kernel_launch: launch failed: %s\n", hipGetErrorName(le));
}
```

```cpp
#include <hip/hip_runtime.h>
#include <cstdio>
#include <cstdint>

#ifndef MK_PER_PHASE
#define MK_PER_PHASE 0
#endif
#ifndef PH_MASK
#define PH_MASK 0x1fff
#endif

#define LAS __attribute__((address_space(3)))
#define GAS __attribute__((address_space(1)))
typedef unsigned short bf16_t;
typedef short bf16x8 __attribute__((ext_vector_type(8)));
typedef short s16x4 __attribute__((ext_vector_type(4)));
typedef float f32x2 __attribute__((ext_vector_type(2)));
typedef float f32x4 __attribute__((ext_vector_type(4)));
typedef float f32x16 __attribute__((ext_vector_type(16)));
typedef unsigned u32x2 __attribute__((ext_vector_type(2)));
typedef unsigned u32x4 __attribute__((ext_vector_type(4)));
typedef GAS unsigned gu32;
typedef int v4i_t __attribute__((ext_vector_type(4)));
typedef int v8i_t __attribute__((ext_vector_type(8)));

constexpr int NB = 8, SEQ = 4096, DM = 2048, DEPTH = 2;
constexpr int T = NB * SEQ;
constexpr int NH = 8, DQK = 64, DV = 128, AW = 1024;
constexpr int SW = 1024, SG = 16, NG = 64, SN = 64;
constexpr int CL = 32;
constexpr int NCH = SEQ / CL;
constexpr int RG = NB * NCH;
constexpr int KAUG = CL * SG + 4 * SN;
constexpr int NEXP = 16, FF = 1024;
constexpr int INC = 8192;
constexpr float EPS = 1e-6f;
constexpr float LOG2E = 1.4426950408889634f;
constexpr int MAXROWS = 2 * T + 32 * 256;
constexpr int MAXTILES = MAXROWS / 256;
constexpr float YSC = 16.0f;
constexpr float WSC = 32.0f;

constexpr size_t MiB = 1u << 20;
constexpr size_t WS_CTL = 0, CTL_ZERO_BYTES = 1 * MiB;
constexpr size_t WS_ROUTE = 1 * MiB;
constexpr size_t WS_ROWMAP = WS_ROUTE + (size_t)T * 16;
constexpr size_t WS_ROWW = WS_ROWMAP + (size_t)MAXROWS * 4;
constexpr size_t WS_TILES = WS_ROWW + (size_t)MAXROWS * 4;
constexpr size_t WS_WRB = WS_TILES + 4096;
constexpr size_t WS_RSTD = WS_WRB + 8 * 8 * 4 * 64 * 16;
static_assert(WS_RSTD + (size_t)T * 4 <= 4 * MiB, "small tables");
constexpr size_t WS_WIN = 4 * MiB;
constexpr size_t WS_WG8 = 20 * MiB;
constexpr size_t WS_WAUP = 36 * MiB;
constexpr size_t WS_WGLU = 40 * MiB;
constexpr size_t WS_WSUP = 42 * MiB;
constexpr size_t WS_WOUT = 46 * MiB;
constexpr size_t WS_W13 = 54 * MiB;
constexpr size_t WS_W2 = 182 * MiB;
constexpr size_t WS_TM = 246 * MiB;
constexpr size_t WS_WST = 294 * MiB;
constexpr size_t WS_XN = 310 * MiB;
constexpr size_t WS_Q = 438 * MiB;
constexpr size_t WS_K = 502 * MiB;
constexpr size_t WS_V = 566 * MiB;
constexpr size_t WS_HID = 438 * MiB;
constexpr size_t WS_Y = 630 * MiB;
constexpr size_t WS_GA = 630 * MiB;
constexpr size_t WS_GB = 694 * MiB;
constexpr size_t WS_AUG = 886 * MiB;
constexpr size_t WS_HLOC = 982 * MiB;
constexpr size_t WS_O = WS_Q;
constexpr size_t WS_XB = 1014 * MiB;
constexpr size_t WS_XN8 = 1142 * MiB;
constexpr size_t WS_END = 1206 * MiB;
static_assert(WS_HID + (size_t)MAXROWS * FF * 2 <= WS_GA, "hid overlay");
constexpr int CW_TMO = 0;
constexpr int CW_BAR = 4096;
constexpr int CW_CNT = 16384;
constexpr int CW_CUR = 16384 + 256;

constexpr int NWAVES = 8;
constexpr int RING_BYTES = 131072;
constexpr int LDS_BYTES = 163840;
constexpr int MISC_OFF = LDS_BYTES - 1024;

#define LDS_WAIT() asm volatile("s_waitcnt lgkmcnt(0)" ::: "memory")
#define VM_WAIT() asm volatile("s_waitcnt vmcnt(0)" ::: "memory")
#define RLX_AGENT __ATOMIC_RELAXED, __HIP_MEMORY_SCOPE_AGENT

typedef __bf16 bf16x2_t __attribute__((ext_vector_type(2)));
__device__ __forceinline__ unsigned cvt_pk_bf16(float lo, float hi) { f32x2 v = {lo, hi}; bf16x2_t b = __builtin_convertvector(v, bf16x2_t); return __builtin_bit_cast(unsigned, b); }
__device__ __forceinline__ unsigned pack_fp8x4(float a, float b, float c, float d) { int w = 0; w = __builtin_amdgcn_cvt_pk_fp8_f32(a, b, w, false); w = __builtin_amdgcn_cvt_pk_fp8_f32(c, d, w, true); return (unsigned)w; }
__device__ __forceinline__ f32x4 unpack_fp8x4(unsigned w) { const f32x2 lo = __builtin_amdgcn_cvt_pk_f32_fp8((int)w, false), hi = __builtin_amdgcn_cvt_pk_f32_fp8((int)w, true); return (f32x4){lo.x, lo.y, hi.x, hi.y}; }
__device__ __forceinline__ f32x4 unpack_bf16x4(u32x2 w) { return (f32x4){__uint_as_float(w.x << 16), __uint_as_float(w.x & 0xffff0000u), __uint_as_float(w.y << 16), __uint_as_float(w.y & 0xffff0000u)}; }
__device__ __forceinline__ float bf_lo(unsigned w) { return __uint_as_float(w << 16); }
__device__ __forceinline__ float bf_hi(unsigned w) { return __uint_as_float(w & 0xffff0000u); }
__device__ __forceinline__ float fast_sigmoid(float x) { return __builtin_amdgcn_rcpf(1.0f + __builtin_amdgcn_exp2f(-x * LOG2E)); }
__device__ __forceinline__ float gelu_tanh(float x) {
    const float z = 0.7978845608028654f * (x + 0.044715f * x * x * x);
    return x * fast_sigmoid(2.0f * z);
}
__device__ __forceinline__ int lane_id() { int l; asm volatile("v_mbcnt_lo_u32_b32 %0, -1, 0\n\tv_mbcnt_hi_u32_b32 %0, -1, %0" : "=v"(l)); return l; }
template <int M> __device__ __forceinline__ float shx(float v) { static_assert(M >= 1 && M <= 16, "shx: 1..16"); return __builtin_bit_cast(float, __builtin_amdgcn_ds_swizzle(__builtin_bit_cast(int, v), (M << 10) | 0x1f)); }
__device__ __forceinline__ float half_sum(float v) { auto rr = __builtin_amdgcn_permlane32_swap(__float_as_uint(v), __float_as_uint(v), false, false); return __uint_as_float(rr[0]) + __uint_as_float(rr[1]); }
template <int CTRL> __device__ __forceinline__ float dpp_add(float v) { return v + __builtin_bit_cast(float, __builtin_amdgcn_update_dpp(0, __builtin_bit_cast(int, v), CTRL, 0xf, 0xf, true)); }
__device__ __forceinline__ float row_sum16(float v) { v = dpp_add<0xB1>(v); v = dpp_add<0x4E>(v); v = dpp_add<0x141>(v); v = dpp_add<0x140>(v); return v; }
__device__ __forceinline__ float sum32(float v) { v = row_sum16(v); v += shx<16>(v); return v; }
__device__ __forceinline__ float wave_sum(float v) { v = row_sum16(v);
    const int b = __builtin_bit_cast(int, v);
    return (__builtin_bit_cast(float, __builtin_amdgcn_readlane(b, 0)) + __builtin_bit_cast(float, __builtin_amdgcn_readlane(b, 16))) + (__builtin_bit_cast(float, __builtin_amdgcn_readlane(b, 32)) + __builtin_bit_cast(float, __builtin_amdgcn_readlane(b, 48))); }

namespace pg8 {
constexpr int BM = 256, BK = 64, HALF = 128, HTB = HALF * BK * 2, STAGE_BYTES = 8 * HTB, NXCD = 8, WGM = 8;
__host__ __device__ __forceinline__ int lds_byte(int r, int c) { const int st = (r >> 4) * 2 + (c >> 5), rr = r & 15, cc = c & 31, ob = rr * 64 + cc * 2; return st * 1024 + (ob ^ (((ob >> 9) & 1) << 5)); }
__host__ __device__ __forceinline__ void stage_rc(int b, int& R, int& C) { const int st = b / 1024, sb = b % 1024, swz = sb ^ (((sb >> 9) & 1) << 5); R = (st >> 1) * 16 + swz / 64; C = (st & 1) * 32 + (swz % 64) / 2; }
__host__ __device__ __forceinline__ int perm32(int rho) { const int n = rho >> 4, i = rho & 15; return 8 * (i >> 2) + 4 * n + (i & 3); }

struct Unit { int pm, pn, z; unsigned aoff; size_t boff; const int* rows; };
struct Gemm { const bf16_t* A; const bf16_t* Bt; int lda, ldb, K; };

struct DenseOrder {
    int nM, nN, nwg, G, c, lda, ldb;
    __device__ void init(int M, int N, int G_, int c_, int lda_, int ldb_) { nM = M / BM; nN = N / BM; nwg = nM * nN; G = G_; c = c_; lda = lda_; ldb = ldb_; }
    __device__ bool next(int i, Unit& u) const {
        const long L = (long)i * G + c; if (L >= nwg) return false;
        int wgid = (int)L; { const int q = nwg / NXCD, r = nwg % NXCD, xcd = wgid % NXCD, off = wgid / NXCD; wgid = (xcd < r ? xcd * (q + 1) : r * (q + 1) + (xcd - r) * q) + off; }
        const int nig = WGM * nN, gid = wgid / nig, fm = gid * WGM, gsz = (nM - fm) < WGM ? (nM - fm) : WGM;
        u.pm = fm + ((wgid % nig) % gsz); u.pn = (wgid % nig) / gsz; u.z = 0;
        u.aoff = (unsigned)u.pm * BM * lda * 2u; u.boff = (size_t)u.pn * BM * ldb * 2; u.rows = nullptr; return true;
    }
};
struct BatchOrder {
    int nM, nN, nz, G, c, lda, ldb, rowsA, rowsB;
    __device__ void init(int nM_, int nN_, int nz_, int G_, int c_, int lda_, int ldb_, int rowsA_, int rowsB_) { nM = nM_; nN = nN_; nz = nz_; G = G_; c = c_; lda = lda_; ldb = ldb_; rowsA = rowsA_; rowsB = rowsB_; }
    __device__ bool next(int i, Unit& u) const {
        const int L = i * G + c; if (L >= nM * nN * nz) return false;
        u.z = L / (nM * nN); const int r = L % (nM * nN); u.pm = r / nN; u.pn = r % nN;
        u.aoff = (unsigned)(u.z * rowsA + u.pm * BM) * (unsigned)lda * 2u; u.boff = (size_t)(u.z * rowsB + u.pn * BM) * ldb * 2; u.rows = nullptr; return true;
    }
};
struct ChainOrder {
    DenseOrder D; unsigned aoff0, aoff1; size_t boff0, boff1;
    __device__ bool next(int i, Unit& u) const { if (!D.next(i >> 1, u)) return false; u.z = i & 1; u.aoff += u.z ? aoff1 : aoff0; u.boff += u.z ? boff1 : boff0; return true; }
};
struct MoeOrder {
    const int* tiles; const int* rowmap; int t0, t1, nN, G, c, lda, ldb, rowsB; bool gather;
    __device__ bool next(int i, Unit& u) const {
        const int L = i * G + c; if (L >= (t1 - t0) * nN) return false;
        const int tl = t0 + L / nN; u.pn = L % nN; const int list = __builtin_amdgcn_readfirstlane(tiles[2 * tl]), row0 = __builtin_amdgcn_readfirstlane(tiles[2 * tl + 1]);
        u.pm = row0 >> 8; u.z = list; u.aoff = (unsigned)row0 * (unsigned)lda * 2u; u.boff = (size_t)((list & 15) * rowsB + u.pn * BM) * ldb * 2; u.rows = gather ? rowmap + row0 : nullptr; return true;
    }
};

#ifndef PG8_ALIGN_EPI
#define PG8_ALIGN_EPI true
#endif
template <class Epi, class Sched, bool GATHER, bool FP8 = false, bool ALIGN_EPI = PG8_ALIGN_EPI>
__device__ __forceinline__ void gemm_phase(LAS unsigned char* lds, const Gemm g, const Sched& S, const Epi& E, int wave_id) {
    const int lane = lane_id(), wid = wave_id, tid = wid * 64 + lane,
              wr = wid >> 2, wc = wid & 3, fr = lane & 15, fq = lane >> 4;
    int K_ = g.K; asm volatile("" : "+s"(K_));
    const int K = K_, nt = K / BK;
    unsigned voffA[2], voffB[2];
#pragma unroll
    for (int i = 0; i < 2; ++i) { int R, C; stage_rc(tid * 16 + i * 8192, R, C); const int Rb = Epi::PERM ? ((R & ~31) + perm32(R & 31)) : R;
        voffA[i] = (unsigned)(R * g.lda + C) * 2u; voffB[i] = (unsigned)(Rb * g.ldb + C) * 2u; }
    const size_t kstep = (size_t)(BK * 2);
    const unsigned hstepA = (unsigned)HALF * (unsigned)g.lda * 2u;
    const size_t hstepB = (size_t)HALF * g.ldb * 2;
    const unsigned ldsw = (unsigned)wid * 1024u;
    const int aoff = lds_byte(wr * 64 + fr, fq * 8), boff = lds_byte(wc * 32 + fr, fq * 8);
#define PG8_SA(b, h) (((b) * 2 + (h)) * HTB)
#define PG8_SB(b, h) ((4 + (b) * 2 + (h)) * HTB)
#define PG8_STAGEB(bufoff, gbase) do { const char* _ub = (const char*)(gbase); asm volatile("" : "+s"(_ub)); _Pragma("unroll") for (int _i = 0; _i < 2; ++_i) \
        __builtin_amdgcn_global_load_lds((const unsigned*)(_ub + voffB[_i]), (LAS unsigned*)(lds + (bufoff) + ldsw + _i * 8192), 16, 0, 0); } while (0)
#define PG8_STAGEA(bufoff, ub, ug, offs, h) do { const char* _ua = GATHER ? (const char*)(ug) : (const char*)(ub) + (size_t)(h) * hstepA; asm volatile("" : "+s"(_ua)); _Pragma("unroll") for (int _i = 0; _i < 2; ++_i) { \
        if constexpr (GATHER) __builtin_amdgcn_global_load_lds((const unsigned*)(_ua + (offs)[h][_i]), (LAS unsigned*)(lds + (bufoff) + ldsw + _i * 8192), 16, 0, 0); \
        else __builtin_amdgcn_global_load_lds((const unsigned*)(_ua + voffA[_i]), (LAS unsigned*)(lds + (bufoff) + ldsw + _i * 8192), 16, 0, 0); } } while (0)
#define PG8_LD2(p) __builtin_shufflevector(*(const LAS v4i_t*)(p), *(const LAS v4i_t*)((p) + 1024), 0, 1, 2, 3, 4, 5, 6, 7)
#define PG8_LDA(dst, b, h) do { _Pragma("unroll") for (int m = 0; m < 4; ++m) dst[m] = PG8_LD2(lds + PG8_SA(b, h) + aoff + m * 2048); } while (0)
#define PG8_LDB(dst, b, h) do { _Pragma("unroll") for (int n = 0; n < 2; ++n) dst[n] = PG8_LD2(lds + PG8_SB(b, h) + boff + n * 2048); } while (0)
#define PG8_HALF(x, k) __builtin_bit_cast(bf16x8, __builtin_shufflevector(x, x, 4 * (k), 4 * (k) + 1, 4 * (k) + 2, 4 * (k) + 3))
#define PG8_MMA(ai, bj, At, Bt) do { __builtin_amdgcn_s_setprio(1); \
        if constexpr (FP8) { _Pragma("unroll") for (int m = 0; m < 4; ++m) _Pragma("unroll") for (int n = 0; n < 2; ++n) \
            acc[ai][bj][m][n] = __builtin_amdgcn_mfma_scale_f32_16x16x128_f8f6f4(Bt[n], At[m], acc[ai][bj][m][n], 0, 0, 0, 0x7f7f7f7f, 0, 0x7f7f7f7f); } \
        else { _Pragma("unroll") for (int m = 0; m < 4; ++m) _Pragma("unroll") for (int n = 0; n < 2; ++n) { \
            acc[ai][bj][m][n] = __builtin_amdgcn_mfma_f32_16x16x32_bf16(PG8_HALF(Bt[n], 0), PG8_HALF(At[m], 0), acc[ai][bj][m][n], 0, 0, 0); \
            acc[ai][bj][m][n] = __builtin_amdgcn_mfma_f32_16x16x32_bf16(PG8_HALF(Bt[n], 1), PG8_HALF(At[m], 1), acc[ai][bj][m][n], 0, 0, 0); } } \
        __builtin_amdgcn_s_setprio(0); } while (0)
#define PG8_WAIT_V(n) asm volatile("s_waitcnt vmcnt(" #n ")" ::: "memory")
#define PG8_WAIT_L(n) asm volatile("s_waitcnt lgkmcnt(" #n ")" ::: "memory")
#define PG8_BAR __builtin_amdgcn_s_barrier()
#define PG8_SCHED __builtin_amdgcn_sched_barrier(0)
#define PG8_UOFFS(dst, u) do { if constexpr (GATHER) { const int _t = wid * 64 + lane_id(); _Pragma("unroll") for (int _i = 0; _i < 2; ++_i) { int _R, _C; stage_rc(_t * 16 + _i * 8192, _R, _C); \
            _Pragma("unroll") for (int _h = 0; _h < 2; ++_h) { int _r = (u).rows[_h * HALF + _R]; _r = _r < 0 ? 0 : _r; dst[_h][_i] = (unsigned)_r * (unsigned)g.lda * 2u + (unsigned)_C * 2u; } } } } while (0)
    Unit cur, nxt; int ui = 0;
    if (!S.next(0, cur)) return;
    f32x4 acc[2][2][4][2];
#pragma unroll
    for (int a = 0; a < 2; ++a)
#pragma unroll
        for (int b = 0; b < 2; ++b)
#pragma unroll
            for (int m = 0; m < 4; ++m)
#pragma unroll
                for (int n = 0; n < 2; ++n) acc[a][b][m][n] = (f32x4){0.f, 0.f, 0.f, 0.f};
    v8i_t At[4], B0[2], B1[2];
    unsigned co[2][2], no[2][2];
    PG8_UOFFS(co, cur);
    const char* gA = (const char*)g.A;
    const char* cA = gA + cur.aoff;
    const char* cB = (const char*)g.Bt + cur.boff;
    PG8_STAGEB(PG8_SB(0, 0), cB); PG8_STAGEB(PG8_SB(0, 1), cB + hstepB); PG8_STAGEA(PG8_SA(0, 0), cA, gA, co, 0); PG8_STAGEA(PG8_SA(0, 1), cA, gA, co, 1);
    if (wr == 1) PG8_BAR;
    PG8_WAIT_V(2); PG8_BAR;
    PG8_STAGEB(PG8_SB(1, 0), cB + kstep); PG8_STAGEA(PG8_SA(1, 0), cA + kstep, gA + kstep, co, 0); PG8_STAGEB(PG8_SB(1, 1), cB + hstepB + kstep);
    PG8_WAIT_V(6); PG8_BAR;
    for (;;) {
        const bool has_next = S.next(ui + 1, nxt);
        const char* nA = has_next ? gA + nxt.aoff : cA; const char* nB = has_next ? (const char*)g.Bt + nxt.boff : cB;
#pragma unroll 1
        for (int t = 0; t < nt; t += 2) {
            const bool last = (t == nt - 2);
            asm volatile("" : "+v"(voffA[0]), "+v"(voffA[1]), "+v"(voffB[0]), "+v"(voffB[1]));
            const char* a1 = cA + (size_t)(t + 1) * kstep; const char* g1 = gA + (size_t)(t + 1) * kstep;
            const char* a2 = last ? nA : cA + (size_t)(t + 2) * kstep; const char* b2 = last ? nB : cB + (size_t)(t + 2) * kstep; const char* g2 = last ? gA : gA + (size_t)(t + 2) * kstep;
            const char* a3 = a2 + kstep; const char* b3 = b2 + kstep; const char* g3 = g2 + kstep;
            if constexpr (GATHER) { if (last) { if (has_next) { PG8_UOFFS(no, nxt); } else {
#pragma unroll
                for (int h = 0; h < 2; ++h)
#pragma unroll
                    for (int i = 0; i < 2; ++i) no[h][i] = co[h][i]; } } }
            PG8_LDB(B0, 0, 0); PG8_LDB(B1, 0, 1); PG8_SCHED; PG8_LDA(At, 0, 0); PG8_STAGEA(PG8_SA(1, 1), a1, g1, co, 1);
            if constexpr (GATHER) { if (last) {
#pragma unroll
                for (int h = 0; h < 2; ++h)
#pragma unroll
                    for (int i = 0; i < 2; ++i) co[h][i] = no[h][i]; } }
            PG8_WAIT_V(8); PG8_WAIT_L(0); PG8_BAR; PG8_MMA(0, 0, At, B0); PG8_MMA(0, 1, At, B1); PG8_BAR; PG8_SCHED;
            PG8_LDA(At, 0, 1); PG8_STAGEB(PG8_SB(0, 0), b2); PG8_STAGEB(PG8_SB(0, 1), b2 + hstepB); PG8_STAGEA(PG8_SA(0, 0), a2, g2, co, 0);
            PG8_WAIT_V(8); PG8_WAIT_L(0); PG8_BAR; PG8_MMA(1, 0, At, B0); PG8_MMA(1, 1, At, B1); PG8_BAR; PG8_SCHED;
            PG8_LDB(B0, 1, 0); PG8_LDB(B1, 1, 1); PG8_SCHED; PG8_LDA(At, 1, 0); PG8_STAGEA(PG8_SA(0, 1), a2, g2, co, 1);
            PG8_WAIT_V(8); PG8_WAIT_L(0); PG8_BAR; PG8_MMA(0, 0, At, B0); PG8_MMA(0, 1, At, B1); PG8_BAR; PG8_SCHED;
            PG8_LDA(At, 1, 1); PG8_STAGEB(PG8_SB(1, 0), b3); PG8_STAGEB(PG8_SB(1, 1), b3 + hstepB); PG8_STAGEA(PG8_SA(1, 0), a3, g3, co, 0);
            PG8_WAIT_V(8); PG8_WAIT_L(0); PG8_BAR; PG8_MMA(1, 0, At, B0); PG8_MMA(1, 1, At, B1); PG8_BAR; PG8_SCHED;
        }
        if constexpr (ALIGN_EPI) { if (wr == 0) PG8_BAR; }
        PG8_WAIT_V(0);
        { Unit eu = cur; eu.pm = __builtin_amdgcn_readfirstlane(eu.pm); eu.pn = __builtin_amdgcn_readfirstlane(eu.pn); eu.z = __builtin_amdgcn_readfirstlane(eu.z); asm volatile("" : "+s"(eu.pm), "+s"(eu.pn), "+s"(eu.z)); const int le = lane_id(), efr = le & 15, efq = le >> 4; bool keep = false;
          if constexpr (Epi::CHAIN) { if (eu.z == 0) { E.mid(acc, eu, wr, wc, efr, efq); keep = true; } else E(acc, eu, wr, wc, efr, efq); } else E(acc, eu, wr, wc, efr, efq);
          if (!has_next) break;
          if (!keep) {
#pragma unroll
            for (int a = 0; a < 2; ++a)
#pragma unroll
                for (int b = 0; b < 2; ++b)
#pragma unroll
                    for (int m = 0; m < 4; ++m)
#pragma unroll
                        for (int n = 0; n < 2; ++n) acc[a][b][m][n] = (f32x4){0.f, 0.f, 0.f, 0.f}; } }
        cur = nxt; cA = nA; cB = nB;
        ++ui;
        if constexpr (ALIGN_EPI) { if (wr == 1) PG8_BAR; }
    }
    PG8_WAIT_V(0);
    if constexpr (!ALIGN_EPI) { if (wr == 0) PG8_BAR; }
    PG8_BAR;
#undef PG8_SA
#undef PG8_SB
#undef PG8_STAGEA
#undef PG8_STAGEB
#undef PG8_LDA
#undef PG8_LDB
#undef PG8_MMA
#undef PG8_LD2
#undef PG8_HALF
#undef PG8_WAIT_V
#undef PG8_WAIT_L
#undef PG8_BAR
#undef PG8_SCHED
#undef PG8_UOFFS
}
}

using pg8::Unit;
__device__ __forceinline__ u32x4 pack8(const f32x4& a, const f32x4& b) { u32x4 w; w.x = cvt_pk_bf16(a[0], a[1]); w.y = cvt_pk_bf16(a[2], a[3]); w.z = cvt_pk_bf16(b[0], b[1]); w.w = cvt_pk_bf16(b[2], b[3]); return w; }
__device__ __forceinline__ void unpack8(const u32x4& w, f32x4& a, f32x4& b) { a = (f32x4){bf_lo(w.x), bf_hi(w.x), bf_lo(w.y), bf_hi(w.y)}; b = (f32x4){bf_lo(w.z), bf_hi(w.z), bf_lo(w.w), bf_hi(w.w)}; }

struct EpiIn {
    static constexpr bool PERM = true, CHAIN = false;
    unsigned char* ws;
    const float* qg; const float* kg;
    LAS float* xch; int wid;
    const float* rs;
    __device__ __forceinline__ void operator()(const f32x4 (&acc)[2][2][4][2], const Unit& u, int wr, int wc, int fr, int fq) const {
        const int row0 = u.pm * 256 + wr * 64 + fr, ct = u.pn, cl = wc * 32 + 8 * fq; float rr[2][4];
#pragma unroll
        for (int ai = 0; ai < 2; ++ai)
#pragma unroll
            for (int m = 0; m < 4; ++m) rr[ai][m] = rs[row0 + ai * 128 + m * 16];
        if (ct < 8) {
            float ssq[2][4][2];
#pragma unroll
            for (int ai = 0; ai < 2; ++ai)
#pragma unroll
                for (int m = 0; m < 4; ++m)
#pragma unroll
                    for (int bj = 0; bj < 2; ++bj) { const f32x4 a = acc[ai][bj][m][0] * rr[ai][m], b = acc[ai][bj][m][1] * rr[ai][m]; float t = (a[0] * a[0] + a[1] * a[1]) + (a[2] * a[2] + a[3] * a[3]) + (b[0] * b[0] + b[1] * b[1]) + (b[2] * b[2] + b[3] * b[3]);
                        t += shx<16>(t); t = half_sum(t); ssq[ai][m][bj] = t;
                        if (fq == 0) xch[wid * 256 + ((ai * 4 + m) * 2 + bj) * 16 + fr] = t; }
            asm volatile("s_waitcnt lgkmcnt(0)" ::: "memory"); __builtin_amdgcn_s_barrier(); asm volatile("" ::: "memory");
            const bool isk = ct >= 4; const float* gp = (isk ? kg : qg) + (wc & 1) * 32 + 8 * fq; const float gs = isk ? 1.0f : 0.125f * LOG2E;
            const f32x4 g0 = *(const f32x4*)gp * gs, g1 = *(const f32x4*)(gp + 4) * gs;
            bf16_t* base = (bf16_t*)(ws + WS_Q + (size_t)(ct >> 2) * (WS_K - WS_Q)); const int c0 = (ct & 3) * 256 + cl;
#pragma unroll
            for (int ai = 0; ai < 2; ++ai)
#pragma unroll
                for (int m = 0; m < 4; ++m) { bf16_t* rp = base + (size_t)(row0 + ai * 128 + m * 16) * AW + c0;
#pragma unroll
                    for (int bj = 0; bj < 2; ++bj) { const float tot = ssq[ai][m][bj] + xch[(wid ^ 1) * 256 + ((ai * 4 + m) * 2 + bj) * 16 + fr]; const float rstd = 1.0f / sqrtf(tot * (1.0f / DQK) + EPS);
                        *(u32x4*)(rp + bj * 128) = pack8(acc[ai][bj][m][0] * g0 * (rstd * rr[ai][m]), acc[ai][bj][m][1] * g1 * (rstd * rr[ai][m])); } }
            asm volatile("s_waitcnt lgkmcnt(0)" ::: "memory"); __builtin_amdgcn_s_barrier(); asm volatile("" ::: "memory");
        } else {
            static_assert(WS_K - WS_Q == WS_V - WS_K && WS_GB > WS_GA, "EpiIn offset arithmetic");
            bf16_t* base = (bf16_t*)(ws + WS_Q + (size_t)(ct >> 2) * (WS_K - WS_Q)); const int c0 = (ct & 3) * 256 + cl;
#pragma unroll
            for (int ai = 0; ai < 2; ++ai)
#pragma unroll
                for (int m = 0; m < 4; ++m) { bf16_t* rp = base + (size_t)(row0 + ai * 128 + m * 16) * AW + c0;
#pragma unroll
                    for (int bj = 0; bj < 2; ++bj) *(u32x4*)(rp + bj * 128) = pack8(acc[ai][bj][m][0] * rr[ai][m], acc[ai][bj][m][1] * rr[ai][m]); }
        }
    }
};
struct EpiGate {
    static constexpr bool PERM = true, CHAIN = false;
    unsigned char* ws; const float* rs;
    __device__ __forceinline__ void operator()(const f32x4 (&acc)[2][2][4][2], const Unit& u, int wr, int wc, int fr, int fq) const {
        const int row0 = u.pm * 256 + wr * 64 + fr, cl = wc * 32 + 8 * fq; int ct = u.pn; constexpr float is0 = 1.0f / WSC; float rr[2][4];
#pragma unroll
        for (int ai = 0; ai < 2; ++ai)
#pragma unroll
            for (int m = 0; m < 4; ++m) rr[ai][m] = rs[row0 + ai * 128 + m * 16] * is0;
        if (ct < 4) {
#pragma unroll
            for (int ai = 0; ai < 2; ++ai)
#pragma unroll
                for (int m = 0; m < 4; ++m) { const int tok = row0 + ai * 128 + m * 16;
#pragma unroll
                    for (int bj = 0; bj < 2; ++bj) { const int ch = ct * 256 + cl + bj * 128, gg = ch >> 4, p0 = ch & 15;
                        *(u32x4*)((bf16_t*)(ws + WS_AUG) + ((size_t)(gg * RG + (tok >> 5)) * KAUG + (tok & 31) * SG + p0)) = pack8(acc[ai][bj][m][0] * rr[ai][m], acc[ai][bj][m][1] * rr[ai][m]); } }
            return; }
        ct -= 4;
        unsigned char* base = ws + WS_GA + (size_t)(ct >> 3) * (WS_GB - WS_GA); const int c0 = (ct & 7) * 256 + cl;
#pragma unroll
        for (int ai = 0; ai < 2; ++ai)
#pragma unroll
            for (int m = 0; m < 4; ++m) { unsigned char* rp = base + (size_t)(row0 + ai * 128 + m * 16) * DM + c0;
#pragma unroll
                for (int bj = 0; bj < 2; ++bj) { const f32x4 a = acc[ai][bj][m][0] * rr[ai][m], b = acc[ai][bj][m][1] * rr[ai][m]; u32x2 w; w.x = 0u; w.y = 0u;
#pragma unroll
                    for (int j = 0; j < 4; ++j) { w.x = __builtin_amdgcn_cvt_pk_u8_f32(fast_sigmoid(a[j]) * 255.0f + 0.5f, j, w.x); w.y = __builtin_amdgcn_cvt_pk_u8_f32(fast_sigmoid(b[j]) * 255.0f + 0.5f, j, w.y); }
                    *(u32x2*)(rp + bj * 128) = w; } }
    }
};
struct EpiBf16Z {
    static constexpr bool PERM = true, CHAIN = false;
    bf16_t* O; int ldc; size_t zstride;
    __device__ __forceinline__ void operator()(const f32x4 (&acc)[2][2][4][2], const Unit& u, int wr, int wc, int fr, int fq) const {
        const int row0 = u.pm * 256 + wr * 64 + fr, c0 = u.pn * 256 + wc * 32 + 8 * fq; bf16_t* base = O + (size_t)u.z * zstride;
#pragma unroll
        for (int ai = 0; ai < 2; ++ai)
#pragma unroll
            for (int m = 0; m < 4; ++m) { bf16_t* rp = base + (size_t)(row0 + ai * 128 + m * 16) * ldc + c0;
#pragma unroll
                for (int bj = 0; bj < 2; ++bj) *(u32x4*)(rp + bj * 128) = pack8(acc[ai][bj][m][0], acc[ai][bj][m][1]); }
    }
};
struct EpiS5 {
    static constexpr bool PERM = true, CHAIN = false;
    const bf16_t* AUG; const float* dskip; bf16_t* Y;
    __device__ __forceinline__ void operator()(const f32x4 (&acc)[2][2][4][2], const Unit& u, int wr, int wc, int fr, int fq) const {
        const int row0 = u.pm * 256 + wr * 64 + fr, gg = u.z;
#pragma unroll
        for (int bj = 0; bj < 2; ++bj) { const int n0 = u.pn * 256 + bj * 128 + wc * 32 + 8 * fq, t = n0 >> 4, p0 = n0 & 15;
            const f32x4 d0 = *(const f32x4*)(dskip + gg * SG + p0), d1 = *(const f32x4*)(dskip + gg * SG + p0 + 4);
            u32x4 uw[2][4];
#pragma unroll
            for (int ai = 0; ai < 2; ++ai)
#pragma unroll
                for (int m = 0; m < 4; ++m) uw[ai][m] = *(const u32x4*)(AUG + ((size_t)(gg * RG + row0 + ai * 128 + m * 16) * KAUG + t * SG + p0));
            __builtin_amdgcn_sched_barrier(0);
#pragma unroll
            for (int ai = 0; ai < 2; ++ai)
#pragma unroll
                for (int m = 0; m < 4; ++m) { const int R = row0 + ai * 128 + m * 16; f32x4 ua, ub; unpack8(uw[ai][m], ua, ub);
                    f32x4 a = acc[ai][bj][m][0] + d0 * ua, b = acc[ai][bj][m][1] + d1 * ub;
#pragma unroll
                    for (int j = 0; j < 4; ++j) { a[j] = gelu_tanh(a[j]); b[j] = gelu_tanh(b[j]); }
                    *(u32x4*)(Y + ((size_t)(R * CL + t) * SW + gg * SG + p0)) = pack8(a, b); }
            __builtin_amdgcn_sched_barrier(0); }
    }
};
template <int MODE> struct EpiMul {
    static constexpr bool PERM = true, XU8 = MODE != 0, CHAIN = false;
    const void* Xv; bf16_t* O; int ldc;
    __device__ __forceinline__ void operator()(const f32x4 (&acc)[2][2][4][2], const Unit& u, int wr, int wc, int fr, int fq) const {
        const int row0 = u.pm * 256 + wr * 64 + fr, c0 = u.pn * 256 + wc * 32 + 8 * fq;
#pragma unroll
        for (int ai = 0; ai < 2; ++ai) {
            u32x4 xv[4][2], ov[4][2];
#pragma unroll
            for (int m = 0; m < 4; ++m)
#pragma unroll
                for (int bj = 0; bj < 2; ++bj) { const size_t ro = (size_t)(row0 + ai * 128 + m * 16) * ldc + c0 + bj * 128;
                    if (XU8) { const u32x2 t = *(const u32x2*)((const unsigned char*)Xv + ro); xv[m][bj].x = t.x; xv[m][bj].y = t.y; } else xv[m][bj] = *(const u32x4*)((const bf16_t*)Xv + ro);
                    if (MODE == 2) ov[m][bj] = *(const u32x4*)(O + ro); }
            __builtin_amdgcn_sched_barrier(0);
#pragma unroll
            for (int m = 0; m < 4; ++m)
#pragma unroll
                for (int bj = 0; bj < 2; ++bj) { const size_t ro = (size_t)(row0 + ai * 128 + m * 16) * ldc + c0 + bj * 128; f32x4 xa, xb;
                    if (XU8) { const unsigned w0 = xv[m][bj].x, w1 = xv[m][bj].y; constexpr float q = 1.0f / 255.0f;
                        xa = (f32x4){(float)(w0 & 0xffu), (float)((w0 >> 8) & 0xffu), (float)((w0 >> 16) & 0xffu), (float)(w0 >> 24)} * q; xb = (f32x4){(float)(w1 & 0xffu), (float)((w1 >> 8) & 0xffu), (float)((w1 >> 16) & 0xffu), (float)(w1 >> 24)} * q; }
                    else unpack8(xv[m][bj], xa, xb);
                    f32x4 a = acc[ai][bj][m][0], b = acc[ai][bj][m][1];
                    if (MODE == 0) {
#pragma unroll
                        for (int j = 0; j < 4; ++j) { a[j] = fast_sigmoid(a[j]); b[j] = fast_sigmoid(b[j]); } }
                    a = a * xa; b = b * xb;
                    if (MODE == 2) { f32x4 oa, ob; unpack8(ov[m][bj], oa, ob); a = a + oa; b = b + ob; }
                    *(u32x4*)(O + ro) = pack8(a, b); }
            __builtin_amdgcn_sched_barrier(0);
        }
    }
};
struct EpiUp {
    static constexpr bool PERM = true, CHAIN = true;
    const unsigned char* GA; const unsigned char* GB; bf16_t* O;
    static __device__ __forceinline__ void unq(const u32x2 t, f32x4& a, f32x4& b) { a = (f32x4){(float)(t.x & 0xffu), (float)((t.x >> 8) & 0xffu), (float)((t.x >> 16) & 0xffu), (float)(t.x >> 24)}; b = (f32x4){(float)(t.y & 0xffu), (float)((t.y >> 8) & 0xffu), (float)((t.y >> 16) & 0xffu), (float)(t.y >> 24)}; }
    __device__ __forceinline__ void mid(f32x4 (&acc)[2][2][4][2], const Unit& u, int wr, int wc, int fr, int fq) const {
        const int row0 = u.pm * 256 + wr * 64 + fr, c0 = u.pn * 256 + wc * 32 + 8 * fq;
#pragma unroll
        for (int ai = 0; ai < 2; ++ai) { u32x2 ga[4][2], gb[4][2];
#pragma unroll
            for (int m = 0; m < 4; ++m)
#pragma unroll
                for (int bj = 0; bj < 2; ++bj) { const size_t ro = (size_t)(row0 + ai * 128 + m * 16) * DM + c0 + bj * 128; ga[m][bj] = *(const u32x2*)(GA + ro); gb[m][bj] = *(const u32x2*)(GB + ro); }
            __builtin_amdgcn_sched_barrier(0);
#pragma unroll
            for (int m = 0; m < 4; ++m)
#pragma unroll
                for (int bj = 0; bj < 2; ++bj) { f32x4 a0, a1, b0, b1; unq(ga[m][bj], a0, a1); unq(gb[m][bj], b0, b1);
#pragma unroll
                    for (int j = 0; j < 4; ++j) { acc[ai][bj][m][0][j] *= a0[j] * __builtin_amdgcn_rcpf(fmaxf(b0[j], 0.5f)); acc[ai][bj][m][1][j] *= a1[j] * __builtin_amdgcn_rcpf(fmaxf(b1[j], 0.5f)); } }
            __builtin_amdgcn_sched_barrier(0); }
    }
    __device__ __forceinline__ void operator()(const f32x4 (&acc)[2][2][4][2], const Unit& u, int wr, int wc, int fr, int fq) const {
        const int row0 = u.pm * 256 + wr * 64 + fr, c0 = u.pn * 256 + wc * 32 + 8 * fq; constexpr float q = 1.0f / 255.0f;
#pragma unroll
        for (int ai = 0; ai < 2; ++ai) { u32x2 gb[4][2];
#pragma unroll
            for (int m = 0; m < 4; ++m)
#pragma unroll
                for (int bj = 0; bj < 2; ++bj) gb[m][bj] = *(const u32x2*)(GB + (size_t)(row0 + ai * 128 + m * 16) * DM + c0 + bj * 128);
            __builtin_amdgcn_sched_barrier(0);
#pragma unroll
            for (int m = 0; m < 4; ++m)
#pragma unroll
                for (int bj = 0; bj < 2; ++bj) { f32x4 b0, b1; unq(gb[m][bj], b0, b1);
#pragma unroll
                    for (int j = 0; j < 4; ++j) { b0[j] = fmaxf(b0[j], 0.5f) * q; b1[j] = fmaxf(b1[j], 0.5f) * q; }
                    *(u32x4*)(O + (size_t)(row0 + ai * 128 + m * 16) * DM + c0 + bj * 128) = pack8(acc[ai][bj][m][0] * b0, acc[ai][bj][m][1] * b1); }
            __builtin_amdgcn_sched_barrier(0); }
    }
};
struct EpiRes {
    static constexpr bool PERM = true, CHAIN = false;
    const float* base32; const bf16_t* base16; bf16_t* out;
    __device__ __forceinline__ void operator()(const f32x4 (&acc)[2][2][4][2], const Unit& u, int wr, int wc, int fr, int fq) const {
        const int row0 = u.pm * 256 + wr * 64 + fr, c0 = u.pn * 256 + wc * 32 + 8 * fq;
#pragma unroll
        for (int ai = 0; ai < 2; ++ai) {
            f32x4 ba[4][2], bb[4][2];
            if (base32) {
#pragma unroll
                for (int m = 0; m < 4; ++m)
#pragma unroll
                    for (int bj = 0; bj < 2; ++bj) { const float* p = base32 + (size_t)(row0 + ai * 128 + m * 16) * DM + c0 + bj * 128; ba[m][bj] = *(const f32x4*)p; bb[m][bj] = *(const f32x4*)(p + 4); }
            } else {
#pragma unroll
                for (int m = 0; m < 4; ++m)
#pragma unroll
                    for (int bj = 0; bj < 2; ++bj) unpack8(*(const u32x4*)(base16 + (size_t)(row0 + ai * 128 + m * 16) * DM + c0 + bj * 128), ba[m][bj], bb[m][bj]);
            }
            __builtin_amdgcn_sched_barrier(0);
#pragma unroll
            for (int m = 0; m < 4; ++m)
#pragma unroll
                for (int bj = 0; bj < 2; ++bj) *(u32x4*)(out + (size_t)(row0 + ai * 128 + m * 16) * DM + c0 + bj * 128) = pack8(ba[m][bj] + acc[ai][bj][m][0], bb[m][bj] + acc[ai][bj][m][1]);
            __builtin_amdgcn_sched_barrier(0);
        }
    }
};
struct EpiSwiglu {
    static constexpr bool PERM = true, CHAIN = false;
    unsigned char* HID;
    __device__ __forceinline__ void operator()(const f32x4 (&acc)[2][2][4][2], const Unit& u, int wr, int wc, int fr, int fq) const {
        const int row0 = u.pm * 256 + wr * 64 + fr, c0 = u.pn * 128 + wc * 32 + 8 * fq; constexpr float is = 1.0f / WSC;
#pragma unroll
        for (int ai = 0; ai < 2; ++ai)
#pragma unroll
            for (int m = 0; m < 4; ++m) { f32x4 a = acc[ai][0][m][0] * is, b = acc[ai][0][m][1] * is;
#pragma unroll
                for (int j = 0; j < 4; ++j) { a[j] = a[j] * fast_sigmoid(a[j]); b[j] = b[j] * fast_sigmoid(b[j]); }
                a = a * (acc[ai][1][m][0] * is); b = b * (acc[ai][1][m][1] * is);
                u32x2 w; w.x = pack_fp8x4(a[0], a[1], a[2], a[3]); w.y = pack_fp8x4(b[0], b[1], b[2], b[3]);
                *(u32x2*)(HID + (size_t)(row0 + ai * 128 + m * 16) * FF + c0) = w; }
    }
};
struct EpiY {
    static constexpr bool PERM = true, CHAIN = false;
    const int* rowmap; const float* roww; unsigned char* Y;
    __device__ __forceinline__ void operator()(const f32x4 (&acc)[2][2][4][2], const Unit& u, int wr, int wc, int fr, int fq) const {
        const int row0 = u.pm * 256 + wr * 64 + fr, c0 = u.pn * 256 + wc * 32 + 8 * fq; unsigned char* base = Y + (size_t)(u.z >> 4) * T * DM;
        int tok[2][4]; float w[2][4];
#pragma unroll
        for (int ai = 0; ai < 2; ++ai)
#pragma unroll
            for (int m = 0; m < 4; ++m) { const int pos = row0 + ai * 128 + m * 16; tok[ai][m] = rowmap[pos]; w[ai][m] = roww[pos] * (YSC / WSC); }
        __builtin_amdgcn_sched_barrier(0);
#pragma unroll
        for (int ai = 0; ai < 2; ++ai)
#pragma unroll
            for (int m = 0; m < 4; ++m) {
                if (tok[ai][m] >= 0) { unsigned char* rp = base + (size_t)tok[ai][m] * DM + c0;
#pragma unroll
                    for (int bj = 0; bj < 2; ++bj) { const f32x4 a = acc[ai][bj][m][0] * w[ai][m], b = acc[ai][bj][m][1] * w[ai][m]; u32x2 o; o.x = pack_fp8x4(a[0], a[1], a[2], a[3]); o.y = pack_fp8x4(b[0], b[1], b[2], b[3]);
                        *(u32x2*)(rp + bj * 128) = o; } } }
    }
};

#define XB_TMO      128
#define XB_XCNT(j)  (256  + 64 * (j))
#define XB_XSUB(j)  (1280 + 64 * (j))
#define XB_XGEN(j)  (2304 + 64 * (j))
#define XB_TOP      3328
#define XB_TOPGEN   3392
#define XCD_BAR_WORDS 3456
#define XB_SPIN_CAP (1u << 22)
__device__ __forceinline__ unsigned xb_ld(unsigned* p)              { return __hip_atomic_load(p, __ATOMIC_RELAXED, __HIP_MEMORY_SCOPE_AGENT); }
__device__ __forceinline__ unsigned xb_add(unsigned* p, unsigned v) { return __hip_atomic_fetch_add(p, v, __ATOMIC_RELAXED, __HIP_MEMORY_SCOPE_AGENT); }
__device__ __forceinline__ unsigned xb_xcc_id() { return (unsigned)__builtin_amdgcn_s_getreg((3 << 11) | 20) & 0xFu; }
#define XB_SPIN(cond, bar) do { unsigned _sp = 0; while (cond) { __builtin_amdgcn_s_sleep(1); \
    if ((++_sp & 255u) == 0u) { if (xb_ld(&(bar)[XB_TMO])) break; if (_sp > XB_SPIN_CAP) { atomicAdd(&(bar)[XB_TMO], 1u); break; } } } } while (0)
struct XcdBarrier { unsigned* bar; unsigned x; volatile LAS unsigned* st; };
__device__ __forceinline__ XcdBarrier xcd_barrier_post(unsigned* bar, volatile LAS unsigned* st) {
    XcdBarrier b; b.bar = bar; b.x = xb_xcc_id(); b.st = st;
    if (threadIdx.x == 0) (void)xb_add(&bar[XB_XCNT(b.x)], 1u);
    return b;
}
__device__ __forceinline__ void xcd_barrier_complete(unsigned* bar, unsigned x, unsigned& nloc, unsigned& nx) {
    const unsigned G = gridDim.x * gridDim.y * gridDim.z;
    unsigned sum, cnt, mine, sp = 0u;
    for (;;) {
        sum = 0u; cnt = 0u; mine = 0u;
#pragma unroll
        for (unsigned j = 0; j < 16; ++j) { const unsigned c = xb_ld(&bar[XB_XCNT(j)]); sum += c; cnt += (c > 0u) ? 1u : 0u; mine = (j == x) ? c : mine; }
        if (sum == G) break;
        __builtin_amdgcn_s_sleep(1);
        if ((++sp & 255u) == 0u) { if (xb_ld(&bar[XB_TMO])) break; if (sp > XB_SPIN_CAP) { atomicAdd(&bar[XB_TMO], 1u); break; } }
    }
    nloc = mine > 0u ? mine : 1u; nx = cnt > 0u ? cnt : 1u;
}
__device__ __forceinline__ void xcd_barrier(const XcdBarrier& b, bool leader) {
    asm volatile("s_waitcnt vmcnt(0)" ::: "memory");
    __syncthreads();
    if (leader) {
        unsigned* bar = b.bar;
        __builtin_amdgcn_s_waitcnt(0);
        unsigned nloc = b.st[0], nx = b.st[1];
        if (nloc == 0u) { xcd_barrier_complete(bar, b.x, nloc, nx); b.st[0] = nloc; b.st[1] = nx; }
        const unsigned old = xb_add(&bar[XB_XSUB(b.x)], 1u);
        const unsigned gen = old / nloc;
        if (old + 1u == (gen + 1u) * nloc) {
            __builtin_amdgcn_fence(__ATOMIC_RELEASE, "agent");
            asm volatile("s_waitcnt vmcnt(0)" ::: "memory");
            const unsigned og = xb_add(&bar[XB_TOP], 1u);
            const unsigned tg = og / nx;
            if (og + 1u == (tg + 1u) * nx) xb_add(&bar[XB_TOPGEN], 1u);
            else XB_SPIN(xb_ld(&bar[XB_TOPGEN]) == tg, bar);
            __builtin_amdgcn_fence(__ATOMIC_ACQUIRE, "agent");
            xb_add(&bar[XB_XGEN(b.x)], 1u);
            asm volatile("s_waitcnt vmcnt(0)" ::: "memory");
        } else {
            XB_SPIN(xb_ld(&bar[XB_XGEN(b.x)]) == gen, bar);
            __builtin_amdgcn_fence(__ATOMIC_ACQUIRE, "agent");
            asm volatile("s_waitcnt vmcnt(0)" ::: "memory");
        }
    }
    __syncthreads();
}

struct Args { const float* in[30]; float* out; unsigned char* ws; int ph_lo, ph_hi, pad0, pad1; };
struct Frame {
    LAS unsigned char* lds;
    int tid, lane, wave, vcu, G;
    const float* const* in;
    float* out; unsigned char* ws;
};
enum { IN_X = 0, IN_NORM1, IN_WIN, IN_QG, IN_KG, IN_LQ1, IN_LK1, IN_LQ2, IN_LK2, IN_HG, IN_WAUP, IN_LRE, IN_LIM, IN_LDT, IN_BRE, IN_BIM, IN_CRE, IN_CIM, IN_SD, IN_WGLU, IN_WSUP, IN_WOUT,
       IN_NORM2, IN_WRG, IN_BRG, IN_WRE, IN_BRE2, IN_W1, IN_W3, IN_W2 };

__device__ __forceinline__ const float* inp(const Frame& F, int i) { const volatile LAS unsigned* t = (const volatile LAS unsigned*)(F.lds + MISC_OFF + 256) + 2 * i;
    const unsigned lo = (unsigned)__builtin_amdgcn_readfirstlane((int)t[0]), hi = (unsigned)__builtin_amdgcn_readfirstlane((int)t[1]); return (const float*)(((unsigned long long)hi << 32) | lo); }

__device__ __forceinline__ void transpose_item_fp8(const float* W, int K, int N, unsigned char* WT, int orow0, LAS unsigned* scr, int k0, int n0, int lane, float sc, const float* gk = nullptr) {
    const int n4 = (lane & 31) * 4, hk = lane >> 5;
#pragma unroll 1
    for (int part = 0; part < 4; ++part) {
        f32x4 a[4], b[4], c[4], d[4];
#pragma unroll
        for (int i = 0; i < 4; ++i) { const int kq = hk + 2 * (part * 4 + i); const float* p = W + (size_t)(k0 + 4 * kq) * N + n0 + n4; a[i] = *(const f32x4*)p; b[i] = *(const f32x4*)(p + N); c[i] = *(const f32x4*)(p + 2 * (size_t)N); d[i] = *(const f32x4*)(p + 3 * (size_t)N);
            if (gk) { const f32x4 gg = *(const f32x4*)(gk + k0 + 4 * kq); a[i] = a[i] * gg.x; b[i] = b[i] * gg.y; c[i] = c[i] * gg.z; d[i] = d[i] * gg.w; } }
#pragma unroll
        for (int i = 0; i < 4; ++i) { const int kq = hk + 2 * (part * 4 + i);
            scr[(n4 + 0) * 33 + kq] = pack_fp8x4(a[i].x * sc, b[i].x * sc, c[i].x * sc, d[i].x * sc); scr[(n4 + 1) * 33 + kq] = pack_fp8x4(a[i].y * sc, b[i].y * sc, c[i].y * sc, d[i].y * sc);
            scr[(n4 + 2) * 33 + kq] = pack_fp8x4(a[i].z * sc, b[i].z * sc, c[i].z * sc, d[i].z * sc); scr[(n4 + 3) * 33 + kq] = pack_fp8x4(a[i].w * sc, b[i].w * sc, c[i].w * sc, d[i].w * sc); }
    }
    LDS_WAIT(); asm volatile("" ::: "memory");
    const int cc = lane & 7;
#pragma unroll
    for (int j = 0; j < 16; ++j) { const int n = (lane >> 3) + 8 * j; const LAS unsigned* sp = scr + n * 33 + 4 * cc;
        u32x4 o; o.x = sp[0]; o.y = sp[1]; o.z = sp[2]; o.w = sp[3];
        *(u32x4*)(WT + (size_t)(orow0 + n) * K + k0 + 16 * cc) = o; }
    LDS_WAIT(); asm volatile("" ::: "memory");
}
__device__ __forceinline__ void transpose_item(const float* W, int K, int N, bf16_t* WT, int orow0, LAS unsigned* scr, int k0, int n0, int lane, const float* gk = nullptr) {
    const int n4 = (lane & 31) * 4, hk = lane >> 5;
#pragma unroll
    for (int half = 0; half < 2; ++half) {
        f32x4 a[8], b[8];
#pragma unroll
        for (int i = 0; i < 8; ++i) { const int kp = hk + 2 * (half * 8 + i); const float* p = W + (size_t)(k0 + 2 * kp) * N + n0 + n4; a[i] = *(const f32x4*)p; b[i] = *(const f32x4*)(p + N); if (gk) { const f32x2 gg = *(const f32x2*)(gk + k0 + 2 * kp); a[i] = a[i] * gg.x; b[i] = b[i] * gg.y; } }
#pragma unroll
        for (int i = 0; i < 8; ++i) { const int kp = hk + 2 * (half * 8 + i);
            scr[(n4 + 0) * 33 + kp] = cvt_pk_bf16(a[i].x, b[i].x); scr[(n4 + 1) * 33 + kp] = cvt_pk_bf16(a[i].y, b[i].y); scr[(n4 + 2) * 33 + kp] = cvt_pk_bf16(a[i].z, b[i].z); scr[(n4 + 3) * 33 + kp] = cvt_pk_bf16(a[i].w, b[i].w); }
    }
    LDS_WAIT(); asm volatile("" ::: "memory");
    const int c = lane & 7;
#pragma unroll
    for (int j = 0; j < 16; ++j) { const int n = (lane >> 3) + 8 * j; const LAS unsigned* sp = scr + n * 33 + 4 * c;
        u32x4 o; o.x = sp[0]; o.y = sp[1]; o.z = sp[2]; o.w = sp[3];
        *(u32x4*)(WT + (size_t)(orow0 + n) * K + k0 + 8 * c) = o; }
    LDS_WAIT(); asm volatile("" ::: "memory");
}
__device__ __forceinline__ void cpow(float lr, float li, float dt, int k, float& re, float& im) {
    const float mag = __builtin_amdgcn_exp2f(lr * dt * (float)k * LOG2E);
    float x = li * dt * 0.15915494309189535f; x = x - floorf(x); float y = x * (float)k; y = y - floorf(y);
    re = mag * __builtin_amdgcn_cosf(y); im = mag * __builtin_amdgcn_sinf(y);
}
__device__ __forceinline__ void s5gen(Frame& F, int l, int g, int q) {
    LAS float* PW = (LAS float*)F.lds;
    LAS float* CC = PW + 2 * 33 * 64 * 2;
    LAS float* BB = CC + 2 * 16 * 64 * 2;
    LAS float* KD = BB + 2 * 64 * 16 * 2;
    const float* lre = inp(F, IN_LRE); const float* lim = inp(F, IN_LIM); const float* ldt = inp(F, IN_LDT);
    const float* bre = inp(F, IN_BRE); const float* bim = inp(F, IN_BIM); const float* cre = inp(F, IN_CRE); const float* cim = inp(F, IN_CIM);
    for (int e = F.tid; e < 2 * 33 * 64; e += 512) { const int dir = e / (33 * 64), d = (e / 64) % 33, n = e & 63; const int gi = (l * 2 + dir) * NG + g;
        const float dt = __builtin_amdgcn_exp2f(ldt[gi] * LOG2E); float re, im; cpow(lre[gi * SN + n], lim[gi * SN + n], dt, d, re, im); PW[e * 2] = re; PW[e * 2 + 1] = im; }
    for (int e = F.tid; e < 2 * 64 * 16; e += 512) { const int dir = e >> 10, n = (e >> 4) & 63, p = e & 15; const int gi = (l * 2 + dir) * NG + g;
        const float dt = __builtin_amdgcn_exp2f(ldt[gi] * LOG2E), lr = lre[gi * SN + n], li = lim[gi * SN + n]; float are, aim; cpow(lr, li, dt, 1, are, aim);
        const float nr = are - 1.0f, den = lr * lr + li * li, fre = (nr * lr + aim * li) / den, fim = (aim * lr - nr * li) / den;
        const float br = bre[(size_t)(gi * SN + n) * SG + p], bi = bim[(size_t)(gi * SN + n) * SG + p];
        BB[e * 2] = fre * br - fim * bi; BB[e * 2 + 1] = fre * bi + fim * br; }
    for (int e = F.tid; e < 2 * 16 * 64; e += 512) { const int dir = e >> 10, p = (e >> 6) & 15, n = e & 63; const int gi = (l * 2 + dir) * NG + g;
        CC[e * 2] = cre[(size_t)(gi * SG + p) * SN + n]; CC[e * 2 + 1] = cim[(size_t)(gi * SG + p) * SN + n]; }
    __syncthreads();
    { const int half = F.tid & 1, p = 4 * q + ((F.tid >> 1) & 3), d = (F.tid >> 3) & 31, dir = F.tid >> 8; float s8[8];
#pragma unroll
      for (int j = 0; j < 8; ++j) s8[j] = 0.f;
      const LAS f32x2* c = (const LAS f32x2*)(CC + (dir * 16 + p) * 128); const LAS f32x2* a = (const LAS f32x2*)(PW + (dir * 33 + d) * 128); const LAS f32x4* b = (const LAS f32x4*)(BB + dir * 2048 + half * 16);
#pragma unroll 4
      for (int n = 0; n < 64; ++n) { const f32x2 cv = c[n], av = a[n]; const float xr = cv.x * av.x - cv.y * av.y, xi = cv.x * av.y + cv.y * av.x;
          const f32x4 b0 = b[n * 8], b1 = b[n * 8 + 1], b2 = b[n * 8 + 2], b3 = b[n * 8 + 3];
          s8[0] += xr * b0.x - xi * b0.y; s8[1] += xr * b0.z - xi * b0.w; s8[2] += xr * b1.x - xi * b1.y; s8[3] += xr * b1.z - xi * b1.w;
          s8[4] += xr * b2.x - xi * b2.y; s8[5] += xr * b2.z - xi * b2.w; s8[6] += xr * b3.x - xi * b3.y; s8[7] += xr * b3.z - xi * b3.w; }
      LAS f32x4* kd = (LAS f32x4*)(KD + ((dir * 32 + d) * 16 + p) * 16 + half * 8);
      kd[0] = (f32x4){s8[0], s8[1], s8[2], s8[3]}; kd[1] = (f32x4){s8[4], s8[5], s8[6], s8[7]}; }
    __syncthreads();
    bf16_t* TMg = (bf16_t*)(F.ws + WS_TM) + (size_t)g * 512 * KAUG; bf16_t* WSg = (bf16_t*)(F.ws + WS_WST) + (size_t)g * 256 * 512;
    for (int e = F.tid; e < 128 * 64; e += 512) { const int t = e >> 8, p = 4 * q + ((e >> 6) & 3), row = t * 16 + p, ch = e & 63, s = ch >> 1, pp0 = (ch & 1) * 8; float v[8];
#pragma unroll
        for (int j = 0; j < 8; ++j) v[j] = t > s ? KD[((t - s) * 16 + p) * 16 + pp0 + j] : (t < s ? KD[8192 + ((s - t) * 16 + p) * 16 + pp0 + j] : KD[p * 16 + pp0 + j] + KD[8192 + p * 16 + pp0 + j]);
        u32x4 o; o.x = cvt_pk_bf16(v[0], v[1]); o.y = cvt_pk_bf16(v[2], v[3]); o.z = cvt_pk_bf16(v[4], v[5]); o.w = cvt_pk_bf16(v[6], v[7]);
        *(u32x4*)(TMg + (size_t)row * KAUG + s * 16 + pp0) = o; }
    for (int e = F.tid; e < 128 * 32; e += 512) { const int t = e >> 7, p = 4 * q + ((e >> 5) & 3), row = t * 16 + p, ch = e & 31, qt = ch >> 3, n0 = (ch & 7) * 8, dir = qt >> 1, d = dir == 0 ? t + 1 : 32 - t; float v[8];
#pragma unroll
        for (int j = 0; j < 8; ++j) { const int n = n0 + j; const float cr = CC[((dir * 16 + p) * 64 + n) * 2], ci = CC[((dir * 16 + p) * 64 + n) * 2 + 1], ar = PW[((dir * 33 + d) * 64 + n) * 2], ai = PW[((dir * 33 + d) * 64 + n) * 2 + 1];
            v[j] = (qt & 1) ? -(cr * ai + ci * ar) : (cr * ar - ci * ai); }
        u32x4 o; o.x = cvt_pk_bf16(v[0], v[1]); o.y = cvt_pk_bf16(v[2], v[3]); o.z = cvt_pk_bf16(v[4], v[5]); o.w = cvt_pk_bf16(v[6], v[7]);
        *(u32x4*)(TMg + (size_t)row * KAUG + 512 + qt * 64 + n0) = o; }
    for (int e = F.tid; e < 64 * 64; e += 512) { const int qt = e >> 10, n = 16 * q + ((e >> 6) & 15), r = qt * 64 + n, ch = e & 63, s = ch >> 1, pp0 = (ch & 1) * 8, dir = qt >> 1, d = dir == 0 ? 31 - s : s; float v[8];
        const float ar = PW[((dir * 33 + d) * 64 + n) * 2], ai = PW[((dir * 33 + d) * 64 + n) * 2 + 1];
#pragma unroll
        for (int j = 0; j < 8; ++j) { const float br = BB[((dir * 64 + n) * 16 + pp0 + j) * 2], bi = BB[((dir * 64 + n) * 16 + pp0 + j) * 2 + 1]; v[j] = (qt & 1) ? (ar * bi + ai * br) : (ar * br - ai * bi); }
        u32x4 o; o.x = cvt_pk_bf16(v[0], v[1]); o.y = cvt_pk_bf16(v[2], v[3]); o.z = cvt_pk_bf16(v[4], v[5]); o.w = cvt_pk_bf16(v[6], v[7]);
        *(u32x4*)(WSg + (size_t)r * 512 + s * 16 + pp0) = o; }
    __syncthreads();
}
__device__ __forceinline__ void ph_conv(Frame& F, int l) {
    for (int it = F.vcu; it < NG * 4; it += F.G) s5gen(F, l, it >> 2, it & 3);
    __syncthreads();
    { u32x4* wrb = (u32x4*)(F.ws + WS_WRB); const float* wrg = inp(F, IN_WRG) + (size_t)l * DM * 4; const float* wre = inp(F, IN_WRE) + (size_t)l * DM * 16; const float* g2 = inp(F, IN_NORM2) + (size_t)l * DM;
      for (int e = F.vcu * 512 + F.tid; e < 8 * 8 * 4 * 64; e += F.G * 512) { const int ln = e & 63, nb = (e >> 6) & 3, st = (e >> 8) & 7, w = e >> 11, n = ln & 15, q = ln >> 4;
          const int p = nb < 3 ? nb : (n >> 2), o = nb < 3 ? n : 16 + (n & 3), c0 = 256 * w + 32 * st + 8 * q; unsigned pk[4];
#pragma unroll
          for (int j2 = 0; j2 < 4; ++j2) { unsigned hb[2];
#pragma unroll
              for (int h = 0; h < 2; ++h) { const int c = c0 + 2 * j2 + h; const float f = p < 3 ? g2[c] * (o < 4 ? wrg[c * 4 + o] : wre[c * 16 + (o - 4)]) : 0.f;
                  const unsigned b0 = cvt_pk_bf16(f, 0.f) & 0xffffu; const float r1 = f - __uint_as_float(b0 << 16);
                  const unsigned b1 = cvt_pk_bf16(r1, 0.f) & 0xffffu; const float r2 = r1 - __uint_as_float(b1 << 16);
                  const unsigned b2 = cvt_pk_bf16(r2, 0.f) & 0xffffu; hb[h] = p == 0 ? b0 : (p == 1 ? b1 : b2); }
              pk[j2] = hb[0] | (hb[1] << 16); }
          wrb[e] = (u32x4){pk[0], pk[1], pk[2], pk[3]}; } }
    LAS unsigned* scr = (LAS unsigned*)(F.lds + F.wave * 17408);
    const int gw = F.vcu * NWAVES + F.wave, NGW = F.G * NWAVES;
    constexpr int I_IN = (DM / 64) * (3072 / 128), I_ING = (DM / 128) * (5120 / 128), I_AUP = (AW / 64) * (DM / 128), I_GLU = (SW / 64) * (SW / 128), I_SUP = (SW / 64) * (DM / 128), I_OUT = (DM / 64) * (DM / 128);
    constexpr int NITEMS = I_IN + I_ING + I_AUP + I_GLU + I_SUP + I_OUT;
    for (int it = gw; it < NITEMS; it += NGW) {
        int r = it;
        if (r < I_IN) { const int nblk = 3072 / 128; transpose_item(inp(F, IN_WIN) + (size_t)l * DM * INC, DM, INC, (bf16_t*)(F.ws + WS_WIN), 128 * (r % nblk), scr, 64 * (r / nblk), 128 * (r % nblk), F.lane, inp(F, IN_NORM1) + (size_t)l * DM); continue; } r -= I_IN;
        if (r < I_ING) { const int nblk = 5120 / 128; transpose_item_fp8(inp(F, IN_WIN) + (size_t)l * DM * INC, DM, INC, F.ws + WS_WG8, 128 * (r % nblk), scr, 128 * (r / nblk), 3072 + 128 * (r % nblk), F.lane, WSC, inp(F, IN_NORM1) + (size_t)l * DM); continue; } r -= I_ING;
        if (r < I_AUP) { const int nblk = DM / 128; transpose_item(inp(F, IN_WAUP) + (size_t)l * AW * DM, AW, DM, (bf16_t*)(F.ws + WS_WAUP), 128 * (r % nblk), scr, 64 * (r / nblk), 128 * (r % nblk), F.lane); continue; } r -= I_AUP;
        if (r < I_GLU) { const int nblk = SW / 128; transpose_item(inp(F, IN_WGLU) + (size_t)l * SW * SW, SW, SW, (bf16_t*)(F.ws + WS_WGLU), 128 * (r % nblk), scr, 64 * (r / nblk), 128 * (r % nblk), F.lane); continue; } r -= I_GLU;
        if (r < I_SUP) { const int nblk = DM / 128; transpose_item(inp(F, IN_WSUP) + (size_t)l * SW * DM, SW, DM, (bf16_t*)(F.ws + WS_WSUP), 128 * (r % nblk), scr, 64 * (r / nblk), 128 * (r % nblk), F.lane); continue; } r -= I_SUP;
        { const int nblk = DM / 128; transpose_item(inp(F, IN_WOUT) + (size_t)l * DM * DM, DM, DM, (bf16_t*)(F.ws + WS_WOUT), 128 * (r % nblk), scr, 64 * (r / nblk), 128 * (r % nblk), F.lane); }
    }
}
__device__ __forceinline__ void ph_conv_moe(Frame& F, int l) {
    const int lane = lane_id();
    LAS unsigned* scr = (LAS unsigned*)(F.lds + F.wave * 17408);
    int gw = F.vcu * NWAVES + F.wave; asm volatile("" : "+s"(gw)); const int NGW = F.G * NWAVES;
    constexpr int I_W1E = (DM / 128) * (FF / 128), I_W2E = (FF / 128) * (DM / 128);
    for (int it = gw; it < NEXP * (2 * I_W1E + I_W2E); it += NGW) {
        int r = it;
        const int e = r / (2 * I_W1E + I_W2E); r -= e * (2 * I_W1E + I_W2E);
        if (r < 2 * I_W1E) { const int w3 = r >= I_W1E; if (w3) r -= I_W1E; const int nblk = FF / 128, n0 = 128 * (r % nblk);
            transpose_item_fp8(inp(F, w3 ? IN_W3 : IN_W1) + ((size_t)l * NEXP + e) * DM * FF, DM, FF, F.ws + WS_W13 + (size_t)e * 2048 * DM, 2 * n0 + w3 * 128, scr, 128 * (r / nblk), n0, lane, WSC); continue; }
        r -= 2 * I_W1E;
        { const int nblk = DM / 128; transpose_item_fp8(inp(F, IN_W2) + ((size_t)l * NEXP + e) * FF * DM, FF, DM, F.ws + WS_W2 + (size_t)e * DM * FF, 128 * (r % nblk), scr, 128 * (r / nblk), 128 * (r % nblk), lane, WSC); }
    }
}
__device__ __forceinline__ void ph_norm1(Frame& F, int l, const float* xin, bool comb) {
    const int gw = F.vcu * NWAVES + F.wave, NGW = F.G * NWAVES; const unsigned char* Y = F.ws + WS_Y; bf16_t* XB = (bf16_t*)(F.ws + WS_XB); float* RS = (float*)(F.ws + WS_RSTD);
    for (int m0 = gw; m0 < T; m0 += 2 * NGW) { f32x4 v[2][8];
        if (!comb) {
#pragma unroll
            for (int h = 0; h < 2; ++h) { const int m = m0 + h * NGW; if (m < T) { const f32x4* xr = (const f32x4*)(xin + (size_t)m * DM) + F.lane;
#pragma unroll
                for (int j = 0; j < 8; ++j) v[h][j] = xr[64 * j]; } }
        } else { u32x2 xv[2][8]; unsigned a[2][8], b[2][8];
#pragma unroll
            for (int h = 0; h < 2; ++h) { const int m = m0 + h * NGW; if (m < T) { const u32x2* xb = (const u32x2*)(XB + (size_t)m * DM) + F.lane; const unsigned* y0 = (const unsigned*)(Y + (size_t)m * DM) + F.lane; const unsigned* y1 = (const unsigned*)(Y + (size_t)(T + m) * DM) + F.lane;
#pragma unroll
                for (int j = 0; j < 8; ++j) { xv[h][j] = xb[64 * j]; a[h][j] = y0[64 * j]; b[h][j] = y1[64 * j]; } } }
            __builtin_amdgcn_sched_barrier(0);
#pragma unroll
            for (int h = 0; h < 2; ++h) { const int m = m0 + h * NGW; if (m < T) {
#pragma unroll
                for (int j = 0; j < 8; ++j) v[h][j] = unpack_bf16x4(xv[h][j]) + (unpack_fp8x4(a[h][j]) + unpack_fp8x4(b[h][j])) * (1.0f / YSC); } } }
        __builtin_amdgcn_sched_barrier(0);
#pragma unroll
        for (int h = 0; h < 2; ++h) { const int m = m0 + h * NGW; if (m < T) { float s = 0.f; u32x2* xb = (u32x2*)(XB + (size_t)m * DM) + F.lane; unsigned* o4 = (unsigned*)(F.ws + WS_XN8 + (size_t)m * DM) + F.lane;
#pragma unroll
            for (int j = 0; j < 8; ++j) { u32x2 w; w.x = cvt_pk_bf16(v[h][j].x, v[h][j].y); w.y = cvt_pk_bf16(v[h][j].z, v[h][j].w); xb[64 * j] = w; const f32x4 r = unpack_bf16x4(w);
                o4[64 * j] = pack_fp8x4(r.x, r.y, r.z, r.w); s += (r.x * r.x + r.y * r.y) + (r.z * r.z + r.w * r.w); }
            const float rstd = 1.0f / sqrtf(wave_sum(s) * (1.0f / DM) + EPS);
            if (F.lane == 0) RS[m] = rstd; } } }
}
__device__ __forceinline__ void ph_horner(Frame& F, int l) {
    const bf16_t* HL = (const bf16_t*)(F.ws + WS_HLOC); bf16_t* AUG = (bf16_t*)(F.ws + WS_AUG);
    for (int cid0 = F.vcu * 4; cid0 < NB * NG * 2; cid0 += F.G * 4) {
        __syncthreads();
        { u32x4 st[16];
#pragma unroll
          for (int i = 0; i < 16; ++i) { const int piece = F.tid + 512 * i, ch = piece >> 11, c = (piece >> 4) & 127, part = piece & 15, cid = cid0 + ch, dir = cid & 1, g = (cid >> 1) & 63, b = cid >> 7;
              st[i] = *(const u32x4*)(HL + ((size_t)g * RG + b * NCH + c) * 256 + dir * 128 + part * 8); }
#pragma unroll
          for (int i = 0; i < 16; ++i) { const int piece = F.tid + 512 * i; *(LAS u32x4*)(F.lds + piece * 16) = st[i]; } }
        __syncthreads();
        if (F.wave < 4) { const int cid = cid0 + F.wave, dir = cid & 1, g = (cid >> 1) & 63, b = cid >> 7, n = F.lane; const int gi = (l * 2 + dir) * NG + g;
            const float dt = __builtin_amdgcn_exp2f(inp(F, IN_LDT)[gi] * LOG2E); float are, aim; cpow(inp(F, IN_LRE)[gi * SN + n], inp(F, IN_LIM)[gi * SN + n], dt, CL, are, aim);
            float hr = 0.f, hi = 0.f; const size_t rbase = (size_t)g * RG + b * NCH; const LAS bf16_t* xs = (const LAS bf16_t*)(F.lds + F.wave * 32768) + n;
#pragma unroll 8
            for (int cc = 0; cc < NCH; ++cc) { const int c = dir == 0 ? cc : NCH - 1 - cc; bf16_t* ap = AUG + (rbase + c) * KAUG + 512 + dir * 128 + n;
                ap[0] = (bf16_t)(cvt_pk_bf16(hr, 0.f) & 0xffffu); ap[64] = (bf16_t)(cvt_pk_bf16(hi, 0.f) & 0xffffu);
                const float xr = __uint_as_float((unsigned)xs[c * 128] << 16), xi = __uint_as_float((unsigned)xs[c * 128 + 64] << 16);
                const float nr = are * hr - aim * hi + xr, ni = are * hi + aim * hr + xi; hr = nr; hi = ni; } }
    }
}

namespace attn {
constexpr int SHM_V = 64 * 128 * 2, SHM_K = 64 * 128 * 2, LDK = AW, HG_OFF = 139264;
#define KSWZ(row, colB) ((row) * 256 + ((colB) ^ (((row) & 7) << 4)))
__device__ __forceinline__ int crow(int r, int hi) { return (r & 3) + 8 * (r >> 2) + 4 * hi; }
__device__ __forceinline__ int v_rd_base(int lane) { return ((lane & 3) << 3) | (((lane >> 2) & 3) << 6) | (((lane >> 4) & 1) << 5) | (((lane >> 5) & 1) << 8); }
constexpr int v_rd_off(int d0, int ks, int half) { return d0 * 512 + ks * 4096 + half * 2048; }
template <int OFF> __device__ __forceinline__ s16x4 tr_read(int vb) { s16x4 r; asm volatile("ds_read_b64_tr_b16 %0, %1 offset:%2" : "=&v"(r) : "v"(vb), "i"(OFF) : "memory"); return r; }
template <int D0> __device__ __forceinline__ void pv_one(f32x16& od, int vb, bf16x8 pa0, bf16x8 pa1, bf16x8 pa2, bf16x8 pa3) {
    const s16x4 l0 = tr_read<v_rd_off(D0, 0, 0)>(vb), h0 = tr_read<v_rd_off(D0, 0, 1)>(vb), l1 = tr_read<v_rd_off(D0, 1, 0)>(vb), h1 = tr_read<v_rd_off(D0, 1, 1)>(vb);
    const s16x4 l2 = tr_read<v_rd_off(D0, 2, 0)>(vb), h2 = tr_read<v_rd_off(D0, 2, 1)>(vb), l3 = tr_read<v_rd_off(D0, 3, 0)>(vb), h3 = tr_read<v_rd_off(D0, 3, 1)>(vb);
    asm volatile("s_waitcnt lgkmcnt(0)" ::: "memory"); __builtin_amdgcn_sched_barrier(0);
#define PK(L, H) (bf16x8){L[0], L[1], L[2], L[3], H[0], H[1], H[2], H[3]}
    od = __builtin_amdgcn_mfma_f32_32x32x16_bf16(pa0, PK(l0, h0), od, 0, 0, 0);
    od = __builtin_amdgcn_mfma_f32_32x32x16_bf16(pa1, PK(l1, h1), od, 0, 0, 0);
    od = __builtin_amdgcn_mfma_f32_32x32x16_bf16(pa2, PK(l2, h2), od, 0, 0, 0);
    od = __builtin_amdgcn_mfma_f32_32x32x16_bf16(pa3, PK(l3, h3), od, 0, 0, 0);
#undef PK
    asm volatile("" : "+v"(od));
}
template <int MP> __device__ __forceinline__ void map_tile(f32x16 (&o)[4], float& lsum, const LAS char* qw, const LAS char* Ks, int vbuf, float dd, float nb) {
    const int ln = lane_id(), r32_ = ln & 31, hi_ = ln >> 5, kbase = r32_ * 256 + ((hi_ * 16) ^ ((r32_ & 7) << 4)), vb = vbuf + v_rd_base(ln); const LAS char* qs = qw + ln * 16;
    f32x16 p0, p1;
#pragma unroll
    for (int r = 0; r < 16; ++r) { p0[r] = 0.f; p1[r] = 0.f; }
    { const int kb = kbase + MP * 128, ksa = (int)(unsigned)(uintptr_t)Ks, qa = (int)(unsigned)(uintptr_t)qs + MP * 4096;
      bf16x8 kf0, kf1, qf;
#define QK_RK0(D0) do { const int ka_ = (kb ^ ((D0) << 5)) + ksa; asm volatile("ds_read_b128 %0, %1" : "=&v"(kf0) : "v"(ka_) : "memory"); } while (0)
#define QK_RK1(D0) do { const int ka_ = (kb ^ ((D0) << 5)) + ksa; asm volatile("ds_read_b128 %0, %1 offset:8192" : "=&v"(kf1) : "v"(ka_) : "memory"); } while (0)
#define QK_RQ(D0) asm volatile("ds_read_b128 %0, %1 offset:%2" : "=&v"(qf) : "v"(qa), "i"((D0) * 1024) : "memory")
#define QK_M0(WAITN) do { asm volatile("s_waitcnt lgkmcnt(" #WAITN ")" : "+v"(kf0), "+v"(qf) :: "memory"); p0 = __builtin_amdgcn_mfma_f32_32x32x16_bf16(kf0, qf, p0, 0, 0, 0); asm volatile("" : "+v"(p0)); } while (0)
#define QK_M1(WAITN) do { asm volatile("s_waitcnt lgkmcnt(" #WAITN ")" : "+v"(kf1), "+v"(qf) :: "memory"); p1 = __builtin_amdgcn_mfma_f32_32x32x16_bf16(kf1, qf, p1, 0, 0, 0); asm volatile("" : "+v"(p1)); } while (0)
      QK_RK0(0); QK_RQ(0); QK_RK1(0);
      QK_M0(1); QK_RK0(1); QK_M1(1); QK_RQ(1); QK_RK1(1);
      QK_M0(1); QK_RK0(2); QK_M1(1); QK_RQ(2); QK_RK1(2);
      QK_M0(1); QK_RK0(3); QK_M1(1); QK_RQ(3); QK_RK1(3);
      QK_M0(1); QK_M1(0);
#undef QK_RK0
#undef QK_RK1
#undef QK_RQ
#undef QK_M0
#undef QK_M1
    }
    asm volatile("" : "+v"(p0), "+v"(p1));
#pragma unroll
    for (int r = 0; r < 16; ++r) { const float cr = (float)((r & 3) + 8 * (r >> 2)); p0[r] = fmaf(fabsf(dd - cr), nb, p0[r]); p1[r] = fmaf(fabsf(dd - 32.0f - cr), nb, p1[r]); }
    float ps = 0.f;
#pragma unroll
    for (int r = 0; r < 16; ++r) { p0[r] = __builtin_amdgcn_exp2f(p0[r]); p1[r] = __builtin_amdgcn_exp2f(p1[r]); ps += p0[r] + p1[r]; }
    lsum += ps;
    bf16x8 pa0, pa1, pa2, pa3;
#define PK4(P, BASE, OUT) do { u32x4 w = {cvt_pk_bf16(P[BASE + 0], P[BASE + 1]), cvt_pk_bf16(P[BASE + 2], P[BASE + 3]), cvt_pk_bf16(P[BASE + 4], P[BASE + 5]), cvt_pk_bf16(P[BASE + 6], P[BASE + 7])}; \
    OUT = *reinterpret_cast<bf16x8*>(&w); } while (0)
    PK4(p0, 0, pa0); PK4(p0, 8, pa1); PK4(p1, 0, pa2); PK4(p1, 8, pa3);
#undef PK4
    __builtin_amdgcn_sched_barrier(0);
    s16x4 fl[4], fh[4];
#define PVK(L, H) (bf16x8){L[0], L[1], L[2], L[3], H[0], H[1], H[2], H[3]}
#define PV_READ(N) do { fl[(N) & 3] = tr_read<v_rd_off((N) & 3, ((N) >> 2) & 3, 0)>(vb); fh[(N) & 3] = tr_read<v_rd_off((N) & 3, ((N) >> 2) & 3, 1)>(vb); } while (0)
#define PV_STEP(N, PA, WAITN) do { \
    asm volatile("s_waitcnt lgkmcnt(" #WAITN ")" : "+v"(fl[(N) & 3]), "+v"(fh[(N) & 3]) :: "memory"); \
    o[(N) & 3] = __builtin_amdgcn_mfma_f32_32x32x16_bf16(PA, PVK(fl[(N) & 3], fh[(N) & 3]), o[(N) & 3], 0, 0, 0); \
    asm volatile("" : "+v"(o[(N) & 3])); \
    if ((N) + 4 < 16) PV_READ((N) + 4); } while (0)
    PV_READ(0); PV_READ(1); PV_READ(2); PV_READ(3);
    PV_STEP(0, pa0, 6); PV_STEP(1, pa0, 6); PV_STEP(2, pa0, 6); PV_STEP(3, pa0, 6);
    PV_STEP(4, pa1, 6); PV_STEP(5, pa1, 6); PV_STEP(6, pa1, 6); PV_STEP(7, pa1, 6);
    PV_STEP(8, pa2, 6); PV_STEP(9, pa2, 6); PV_STEP(10, pa2, 6); PV_STEP(11, pa2, 6);
    PV_STEP(12, pa3, 6); PV_STEP(13, pa3, 4); PV_STEP(14, pa3, 2); PV_STEP(15, pa3, 0);
#undef PV_STEP
#undef PV_READ
#undef PVK
}
__device__ __forceinline__ void stage_offs(unsigned (&ko)[2], unsigned (&vo)[2], int wid, int lane) {
#pragma unroll
    for (int i = 0; i < 2; ++i) { const int o = wid * 2048 + i * 1024 + lane * 16;
        { const int row = o >> 8, colB = (o & 255) ^ ((row & 7) << 4); ko[i] = (unsigned)(row * LDK * 2 + colB); }
        { const int sub = o >> 9, within = o & 511, kk = (sub >> 2) * 8 + (within >> 6), c = (sub & 3) * 32 + ((within & 63) >> 1);
          vo[i] = (unsigned)(kk * LDK * 2 + c * 2); } }
}
__device__ __forceinline__ void stage_kv(const char* Kt, const char* Vt, LAS char* Kd, LAS char* Vd, int wid) {
    unsigned ko[2], vo[2]; stage_offs(ko, vo, wid, lane_id());
    asm volatile("" : "+s"(Kt), "+s"(Vt));
#pragma unroll
    for (int i = 0; i < 2; ++i) {
        __builtin_amdgcn_global_load_lds((const unsigned*)(Kt + ko[i]), (LAS unsigned*)(Kd + wid * 2048 + i * 1024), 16, 0, 0);
        __builtin_amdgcn_global_load_lds((const unsigned*)(Vt + vo[i]), (LAS unsigned*)(Vd + wid * 2048 + i * 1024), 16, 0, 0); }
}
__device__ __forceinline__ void attn_unit(const bf16_t* Qb, const bf16_t* Kh, const bf16_t* Vh, bf16_t* Ob, int q0, int jlo, int jhi, float nb, const volatile LAS float* sbox, const float* hgain, LAS char* lds, int wave_id) {
    const int lane = lane_id(), wid = wave_id, tid = wid * 64 + lane, r32 = lane & 31, hi = lane >> 5;
    LAS char* V_lds = lds; LAS char* K_lds = lds + 2 * SHM_V; LAS float* wsf = (LAS float*)(lds + 2 * SHM_V + 2 * SHM_K) + wid * 128;
    LAS char* qw = lds + 2 * SHM_V + 2 * SHM_K + 4096 + wid * 8192; LAS char* qs = qw + lane * 16;
    stage_kv((const char*)(Kh + (size_t)jlo * 64 * LDK), (const char*)(Vh + (size_t)jlo * 64 * LDK), K_lds, V_lds, wid);
    { const bf16_t* Qw = Qb + (size_t)(wid * 32 + r32) * LDK + hi * 8; bf16x8 qv[8];
#pragma unroll
      for (int d0 = 0; d0 < 8; ++d0) qv[d0] = *(const bf16x8*)(Qw + d0 * 16);
#pragma unroll
      for (int d0 = 0; d0 < 8; ++d0) *(LAS bf16x8*)(qs + d0 * 1024) = qv[d0]; }
    f32x16 o1[4], o2[4];
#pragma unroll
    for (int d = 0; d < 4; ++d)
#pragma unroll
        for (int r = 0; r < 16; ++r) { o1[d][r] = 0.f; o2[d][r] = 0.f; }
    float l1 = 0.f, l2 = 0.f;
    const int vb0 = (int)(unsigned)(uintptr_t)V_lds;
    float dd = (float)(q0 + wid * 32 + r32 - 4 * hi - 64 * jlo);
    __syncthreads();
    for (int j = jlo; j < jhi; ++j) {
        const int b = (j - jlo) & 1;
        if (j + 1 < jhi) { size_t tb = (size_t)(j + 1) * 64 * LDK * 2; asm volatile("" : "+s"(tb));
            stage_kv((const char*)Kh + tb, (const char*)Vh + tb, K_lds + (b ^ 1) * SHM_K, V_lds + (b ^ 1) * SHM_V, wid); }
        __builtin_amdgcn_sched_barrier(0);
        map_tile<0>(o1, l1, qw, K_lds + b * SHM_K, vb0 + b * SHM_V, dd, nb);
        __builtin_amdgcn_sched_barrier(0);
        map_tile<1>(o2, l2, qw, K_lds + b * SHM_K, vb0 + b * SHM_V, dd, nb);
        __builtin_amdgcn_sched_barrier(0);
        dd -= 64.0f;
        __syncthreads();
    }
    const float lam = sbox[1], oscale = sbox[2];
    const int lane_e = lane_id(), r32e = lane_e & 31, hie = lane_e >> 5;
    l1 = half_sum(l1); l2 = half_sum(l2);
    if (hie == 0) { wsf[r32e] = l1; wsf[32 + r32e] = l2; }
    LDS_WAIT();
    float hg[4];
#pragma unroll
    for (int d = 0; d < 4; ++d) hg[d] = ((const LAS float*)(lds + HG_OFF))[d * 32 + r32e];
#pragma unroll
    for (int r = 0; r < 16; ++r) { const int row = crow(r, hie); const float a1 = __builtin_amdgcn_rcpf(wsf[row]), a2 = lam * __builtin_amdgcn_rcpf(wsf[32 + row]); float ss = 0.f;
#pragma unroll
        for (int d = 0; d < 4; ++d) { const float v = o1[d][r] * a1 - o2[d][r] * a2; o1[d][r] = v; ss += v * v; }
        ss = sum32(ss);
        const float rs = 1.0f / sqrtf(ss * (1.0f / DV) + EPS);
        bf16_t* op = Ob + (size_t)(wid * 32 + row) * LDK + r32e;
#pragma unroll
        for (int d = 0; d < 4; ++d) op[d * 32] = (bf16_t)(cvt_pk_bf16(o1[d][r] * rs * hg[d], 0.f) & 0xffffu); }
    __syncthreads();
}
}
__device__ __forceinline__ void ph_attn(Frame& F, int l) {
    const float lam_init = 0.8f - 0.6f * expf(-0.3f * (float)l);
    const float s1 = wave_sum(inp(F, IN_LQ1)[l * DQK + F.lane] * inp(F, IN_LK1)[l * DQK + F.lane]), s2 = wave_sum(inp(F, IN_LQ2)[l * DQK + F.lane] * inp(F, IN_LK2)[l * DQK + F.lane]);
    const float lam = expf(s1) - expf(s2) + lam_init;
    float gqm = fabsf(inp(F, IN_QG)[l * DQK + F.lane]), gkm = fabsf(inp(F, IN_KG)[l * DQK + F.lane]);
    gqm = fmaxf(gqm, shx<1>(gqm)); gqm = fmaxf(gqm, shx<2>(gqm)); gqm = fmaxf(gqm, shx<4>(gqm)); gqm = fmaxf(gqm, shx<8>(gqm)); gqm = fmaxf(gqm, shx<16>(gqm));
    gkm = fmaxf(gkm, shx<1>(gkm)); gkm = fmaxf(gkm, shx<2>(gkm)); gkm = fmaxf(gkm, shx<4>(gkm)); gkm = fmaxf(gkm, shx<8>(gkm)); gkm = fmaxf(gkm, shx<16>(gkm));
    { auto r1 = __builtin_amdgcn_permlane32_swap(__float_as_uint(gqm), __float_as_uint(gqm), false, false); gqm = fmaxf(__uint_as_float(r1[0]), __uint_as_float(r1[1]));
      auto r2 = __builtin_amdgcn_permlane32_swap(__float_as_uint(gkm), __float_as_uint(gkm), false, false); gkm = fmaxf(__uint_as_float(r2[0]), __uint_as_float(r2[1])); }
    const float thr = 2.0f * (8.0f * gqm * gkm * LOG2E) + 40.0f;
    const bf16_t* Q = (const bf16_t*)(F.ws + WS_Q); const bf16_t* Kb = (const bf16_t*)(F.ws + WS_K); const bf16_t* V = (const bf16_t*)(F.ws + WS_V); bf16_t* O = (bf16_t*)(F.ws + WS_O);
    const float* hgain = inp(F, IN_HG) + l * DV;
    volatile LAS float* sbox = (volatile LAS float*)(F.lds + MISC_OFF) + 24;
    if (F.tid == 0) { sbox[0] = thr; sbox[1] = lam; sbox[2] = 1.0f - lam_init; }
    if (F.tid < DV) ((LAS float*)(F.lds + attn::HG_OFF))[F.tid] = hgain[F.tid] * (1.0f - lam_init);
    __syncthreads();
    for (int rnd = 0; rnd * F.G < NB * NH * 16; ++rnd) { int h, b, qb;
        if (F.G == 256) {
            const int grp = F.vcu >> 7, w = F.vcu & 127, rank = grp == 0 ? (rnd == 0 ? 0 : rnd == 1 ? 2 : rnd == 2 ? 6 : 7) : (rnd == 0 ? 1 : rnd == 1 ? 3 : rnd == 2 ? 4 : 5);
            h = (NH - 1) - rank; b = w >> 4; qb = ((w & 15) + ((rnd & 1) << 3)) & 15;
        } else { const int pos = (rnd & 1) ? F.G - 1 - F.vcu : F.vcu, u = rnd * F.G + pos; if (u >= NB * NH * 16) continue;
            h = (NH - 1) - (u >> 7); b = (u >> 4) & 7; qb = u & 15; }
        const float slope = exp2f(-(float)(h + 1));
        const float dstar = sbox[0] / (slope * LOG2E); const int D = __builtin_amdgcn_readfirstlane(dstar >= (float)SEQ ? SEQ : (int)dstar);
        const int q0 = qb * 256; const int jlo = (q0 - D) <= 0 ? 0 : (q0 - D) >> 6; int jhi = ((q0 + 255 + D) >> 6) + 1; jhi = jhi > SEQ / 64 ? SEQ / 64 : jhi;
        const size_t rowb = (size_t)b * SEQ;
        attn::attn_unit(Q + (rowb + q0) * AW + h * DV, Kb + rowb * AW + h * DV, V + rowb * AW + h * DV, O + (rowb + q0) * AW + h * DV, q0, jlo, jhi, -slope * LOG2E, sbox, hgain, (LAS char*)F.lds, F.wave);
        if (rnd == (F.vcu & 3)) { ph_conv_moe(F, l); __syncthreads(); } }
}

constexpr int R_PITCH = 4096 + 32;
constexpr int R_BUF = 16 * R_PITCH;
constexpr int R_RED = 2 * R_BUF;
constexpr int R_SC = R_RED + 8 * 2112;
constexpr int R_RS = R_SC + 2048;
constexpr int R_CNT = R_RS + 64;
static_assert(R_CNT + 128 <= MISC_OFF, "router LDS map");
__device__ __forceinline__ void r_stage(const bf16_t* XB, int blk, LAS unsigned char* buf, int wave, int lane) {
    const char* src = (const char*)(XB + (size_t)blk * 16 * DM);
    asm volatile("" : "+s"(src));
#pragma unroll
    for (int i = 0; i < 8; ++i) { const int c = wave * 8 + i, row = c >> 2, qt = c & 3;
        __builtin_amdgcn_global_load_lds((const unsigned*)(src + row * 4096 + qt * 1024 + lane * 16), (LAS unsigned*)(buf + row * R_PITCH + qt * 1024), 16, 0, 0); }
}
__device__ __forceinline__ void ph_norm2_route(Frame& F, int l, bool count = true) {
    LAS unsigned char* L = (LAS unsigned char*)F.lds; LAS unsigned* lcnt = (LAS unsigned*)(L + R_CNT); LAS float* sc = (LAS float*)(L + R_SC); LAS float* rs = (LAS float*)(L + R_RS);
    if (F.tid < 32) lcnt[F.tid] = 0u;
    const int lane = F.lane, w = F.wave, n16 = lane & 15, q = lane >> 4;
    bf16x8 Bf[8][4];
    { const bf16x8* wb = (const bf16x8*)(F.ws + WS_WRB) + (size_t)w * 32 * 64 + lane;
#pragma unroll
      for (int st = 0; st < 8; ++st)
#pragma unroll
          for (int nb = 0; nb < 4; ++nb) Bf[st][nb] = wb[(st * 4 + nb) * 64]; }
    const f32x4 gv = *(const f32x4*)(inp(F, IN_NORM2) + (size_t)l * DM + 256 * w + 4 * lane);
    const bf16_t* XB = (const bf16_t*)(F.ws + WS_XB); unsigned char* X8 = F.ws + WS_XN;
    const float* brg = inp(F, IN_BRG) + l * 4; const float* bre = inp(F, IN_BRE2) + l * 16;
    constexpr int NBLK = T / 16;
    int blk = F.vcu;
    if (blk < NBLK) r_stage(XB, blk, L, w, lane);
    for (int it = 0; blk < NBLK; blk += F.G, ++it) {
        LAS unsigned char* buf = L + (it & 1) * R_BUF;
        VM_WAIT(); __syncthreads();
        if (blk + F.G < NBLK) r_stage(XB, blk + F.G, L + ((it + 1) & 1) * R_BUF, w, lane);
        float zr = 0.f; asm volatile("" : "+v"(zr));
        f32x4 a0 = {zr, zr, zr, zr}, a1 = a0, a2 = a0, a3 = a0, aS = a0;
        const LAS unsigned char* ap = buf + n16 * R_PITCH + (256 * w + 8 * q) * 2;
#pragma unroll
        for (int st = 0; st < 8; ++st) { const bf16x8 A = *(const LAS bf16x8*)(ap + st * 64);
            a0 = __builtin_amdgcn_mfma_f32_16x16x32_bf16(A, Bf[st][0], a0, 0, 0, 0); a1 = __builtin_amdgcn_mfma_f32_16x16x32_bf16(A, Bf[st][1], a1, 0, 0, 0);
            a2 = __builtin_amdgcn_mfma_f32_16x16x32_bf16(A, Bf[st][2], a2, 0, 0, 0); a3 = __builtin_amdgcn_mfma_f32_16x16x32_bf16(A, Bf[st][3], a3, 0, 0, 0);
            aS = __builtin_amdgcn_mfma_f32_16x16x32_bf16(A, A, aS, 0, 0, 0); }
        { LAS float* red = (LAS float*)(L + R_RED + w * 2112); const f32x4 as = (a0 + a1) + a2;
#pragma unroll
          for (int i = 0; i < 4; ++i) { red[i * 64 + lane] = as[i]; red[256 + i * 64 + lane] = a3[i]; }
          const int di = n16 & 3; const float dg = di == 0 ? aS[0] : (di == 1 ? aS[1] : (di == 2 ? aS[2] : aS[3]));
          if ((n16 >> 2) == q) red[512 + n16] = dg; }
        __syncthreads();
        { const int r = F.tid >> 5, n = F.tid & 31, ro = (r & 3) * 64 + 16 * (r >> 2); float ss = 0.f, lg = 0.f;
#pragma unroll
          for (int w2 = 0; w2 < 8; ++w2) { const LAS float* rw = (const LAS float*)(L + R_RED + w2 * 2112); ss += rw[512 + r];
              if (n < 16) lg += rw[ro + n]; else if (n < 20) lg += (rw[256 + ro + (n - 16)] + rw[256 + ro + 4 + (n - 16)]) + rw[256 + ro + 8 + (n - 16)]; }
          const float rstd = 1.0f / sqrtf(ss * (1.0f / DM) + EPS);
          sc[r * 32 + n] = lg * rstd; if (n == 0) rs[r] = rstd; }
        __syncthreads();
        { const LAS unsigned char* xp = buf + (256 * w + 4 * lane) * 2; unsigned char* op = X8 + (size_t)blk * 16 * DM + 256 * w + 4 * lane;
#pragma unroll
          for (int r = 0; r < 16; ++r) { const u32x2 xv = *(const LAS u32x2*)(xp + r * R_PITCH); const f32x4 y = unpack_bf16x4(xv) * rs[r] * gv;
              *(unsigned*)(op + (size_t)r * DM) = pack_fp8x4(y.x, y.y, y.z, y.w); } }
        if (F.tid < 16) { const LAS float* lg = sc + 32 * F.tid; float gl[4];
#pragma unroll
            for (int k = 0; k < 4; ++k) gl[k] = lg[k] + brg[k];
            int gi = 0; float gm = gl[0];
#pragma unroll
            for (int k = 1; k < 4; ++k) if (gl[k] > gm) { gm = gl[k]; gi = k; }
            float gs = 0.f;
#pragma unroll
            for (int k = 0; k < 4; ++k) gs += expf(gl[k] - gm);
            const float gwt = 1.0f / gs;
            float el[4];
#pragma unroll
            for (int k = 0; k < 4; ++k) el[k] = lg[4 + gi * 4 + k] + bre[gi * 4 + k];
            int i0 = 0; float v0 = el[0];
#pragma unroll
            for (int k = 1; k < 4; ++k) if (el[k] > v0) { v0 = el[k]; i0 = k; }
            int i1 = -1; float v1 = -3.0e38f;
#pragma unroll
            for (int k = 0; k < 4; ++k) if (k != i0 && el[k] > v1) { v1 = el[k]; i1 = k; }
            const float e1x = expf(v1 - v0), w0 = gwt / (1.0f + e1x), w1 = gwt * e1x / (1.0f + e1x);
            const int e0 = gi * 4 + i0, e1 = gi * 4 + i1;
            u32x4 rt; rt.x = (unsigned)e0; rt.y = (unsigned)e1; rt.z = __float_as_uint(w0); rt.w = __float_as_uint(w1);
            *(u32x4*)(F.ws + WS_ROUTE + (size_t)(blk * 16 + F.tid) * 16) = rt;
            if (count) { atomicAdd((unsigned*)&lcnt[e0], 1u); atomicAdd((unsigned*)&lcnt[16 + e1], 1u); } }
    }
    __syncthreads();
    if (F.tid < 32) { const unsigned c = lcnt[F.tid]; if (c) atomicAdd((unsigned*)(F.ws + WS_CTL) + CW_CNT + l * 32 + F.tid, c); }
    __syncthreads();
}
__device__ __forceinline__ void ph_route2(Frame& F, int l) {
    LAS int* lb = (LAS int*)F.lds;
    unsigned* ctl = (unsigned*)(F.ws + WS_CTL); int* tiles = (int*)(F.ws + WS_TILES); int* rowmap = (int*)(F.ws + WS_ROWMAP); float* roww = (float*)(F.ws + WS_ROWW);
    if (F.wave == 0) { const int ln = F.lane; const int c = ln < 32 ? (int)__hip_atomic_load(ctl + CW_CNT + l * 32 + ln, RLX_AGENT) : 0, pc = (c + 255) & ~255;
        if (ln < 32) lb[64 + ln] = pc;
        LDS_WAIT(); asm volatile("" ::: "memory");
        int base = 0;
#pragma unroll
        for (int j = 0; j < 32; ++j) { const int v = lb[64 + j]; base += j < ln ? v : 0; }
        if (ln < 32) { lb[ln] = base; lb[32 + ln] = c; }
        if (blockIdx.x == 0 && ln < 32) { for (int k = 0; k < pc; k += 256) { const int ti = (base + k) >> 8; tiles[2 * ti] = ln; tiles[2 * ti + 1] = base + k; }
            if (ln == 16) tiles[2 * MAXTILES + 1] = base >> 8;
            if (ln == 31) { tiles[2 * MAXTILES] = 0; tiles[2 * MAXTILES + 2] = (base + pc) >> 8; } } }
    __syncthreads();
    if (blockIdx.x == 0) { for (int i = 0; i < 32; ++i) { const int s = lb[i] + lb[32 + i], e = lb[i] + lb[64 + i]; for (int p = s + F.tid; p < e; p += 512) { rowmap[p] = -1; roww[p] = 0.f; } } }
    const int gw = F.vcu * NWAVES + F.wave, NGW = F.G * NWAVES;
    for (int ch = gw; ch < T / 64; ch += NGW) { const int t = ch * 64 + F.lane; const u32x4 rt = *(const u32x4*)(F.ws + WS_ROUTE + (size_t)t * 16); const unsigned long long lt = (1ull << F.lane) - 1ull;
#pragma unroll
        for (int s = 0; s < 2; ++s) { const int lid = (int)(s ? rt.y : rt.x); const float w = __uint_as_float(s ? rt.w : rt.z); int mycnt = 0, rank = 0;
#pragma unroll
            for (int L = 0; L < 16; ++L) { const unsigned long long m = __ballot(lid == L); if (F.lane == L) mycnt = __popcll(m); if (lid == L) rank = __popcll(m & lt); }
            unsigned old = 0u; if (F.lane < 16 && mycnt > 0) old = atomicAdd(ctl + CW_CUR + l * 32 + s * 16 + F.lane, (unsigned)mycnt);
            const int oldL = __builtin_amdgcn_ds_bpermute(lid << 2, (int)old);
            const int pos = lb[s * 16 + lid] + oldL + rank;
            rowmap[pos] = t; roww[pos] = w; } }
}

constexpr int PH_PER_LAYER = 13, N_PHASES = DEPTH * PH_PER_LAYER;
__device__ __forceinline__ void moe_w2(Frame& F) {
    const int* tiles = (const int*)(F.ws + WS_TILES);
    pg8::Gemm g{(const bf16_t*)(F.ws + WS_HID), (const bf16_t*)(F.ws + WS_W2), FF / 2, FF / 2, FF / 2};
    pg8::MoeOrder S{tiles, (const int*)(F.ws + WS_ROWMAP), 0, __builtin_amdgcn_readfirstlane(tiles[2 * MAXTILES + 2]), DM / 256, F.G, F.vcu, FF / 2, FF / 2, DM, false};
    EpiY E{(const int*)(F.ws + WS_ROWMAP), (const float*)(F.ws + WS_ROWW), F.ws + WS_Y};
    pg8::gemm_phase<EpiY, pg8::MoeOrder, false, true>(F.lds, g, S, E, F.wave);
}
__device__ __forceinline__ void ph_combine(Frame& F) {
    const int gw = F.vcu * NWAVES + F.wave, NGW = F.G * NWAVES; const unsigned char* Y = F.ws + WS_Y; const bf16_t* XB = (const bf16_t*)(F.ws + WS_XB); constexpr float iy = 1.0f / YSC;
    for (int m = gw; m < T; m += NGW) { f32x4* xo = (f32x4*)(F.out + (size_t)m * DM) + F.lane; const u32x2* xb = (const u32x2*)(XB + (size_t)m * DM) + F.lane; const unsigned* y0 = (const unsigned*)(Y + (size_t)m * DM) + F.lane; const unsigned* y1 = (const unsigned*)(Y + (size_t)(T + m) * DM) + F.lane;
        u32x2 xv[8]; unsigned a[8], b[8];
#pragma unroll
        for (int j = 0; j < 8; ++j) { xv[j] = xb[64 * j]; a[j] = y0[64 * j]; b[j] = y1[64 * j]; }
#pragma unroll
        for (int j = 0; j < 8; ++j) xo[64 * j] = unpack_bf16x4(xv[j]) + (unpack_fp8x4(a[j]) + unpack_fp8x4(b[j])) * iy; }
}
__global__ void __launch_bounds__(NWAVES * 64, 2) fwd(Args args) {
    extern __shared__ __attribute__((aligned(16))) unsigned char lds_raw[];
    Frame F;
    F.lds = (LAS unsigned char*)lds_raw;
    F.tid = threadIdx.x; F.lane = F.tid & 63; F.wave = __builtin_amdgcn_readfirstlane(F.tid >> 6);
    F.G = gridDim.x; { const int bx = blockIdx.x; F.vcu = (F.G % 8 == 0) ? (bx % 8) * (F.G / 8) + bx / 8 : bx; }
    F.in = args.in; F.out = args.out; F.ws = args.ws;
    volatile LAS unsigned* MISC = (volatile LAS unsigned*)(F.lds + MISC_OFF);
    for (int u = F.tid; u < 256; u += NWAVES * 64) MISC[u] = 0u;
    __syncthreads();
    if (F.tid == 0) {
#pragma unroll
        for (int i = 0; i < 30; ++i) { const unsigned long long p = (unsigned long long)args.in[i]; MISC[64 + 2 * i] = (unsigned)p; MISC[65 + 2 * i] = (unsigned)(p >> 32); } }
    __syncthreads();
    XcdBarrier bar; bar.bar = (unsigned*)(F.ws + WS_CTL) + CW_BAR; bar.x = 0; bar.st = nullptr;
#if !MK_PER_PHASE
    bar = xcd_barrier_post((unsigned*)(F.ws + WS_CTL) + CW_BAR, MISC + 8);
#endif
#if MK_PER_PHASE
#define GRID_BAR() do { } while (0)
#else
#define GRID_BAR() xcd_barrier(bar, F.wave == 0 && lane_id() == 0)
#endif
#if MK_PER_PHASE
    const int lo = args.ph_lo, hi = args.ph_hi;
#else
    constexpr int lo = 0, hi = N_PHASES;
#endif
    for (int l = 0; l < DEPTH; ++l) {
        const int pb = l * PH_PER_LAYER;
#define IN(k) ((((PH_MASK) >> (k)) & 1) && lo <= pb + (k) && pb + (k) < hi)
#define FRESH() do { size_t z_ = 0; asm volatile("" : "+s"(z_)); F.ws = args.ws + z_; F.out = args.out + z_; F.lane = lane_id(); F.tid = F.wave * 64 + F.lane; } while (0)
#define ONCE() for (int once_ = 0; once_ < 1; ++once_)
#define SEAM(k) do { if (IN(k) && (pb + (k) + 1) < hi) GRID_BAR(); } while (0)
        if (IN(0)) ONCE() { FRESH();
#pragma unroll 1
            for (int step = 0; step < 2; ++step) { FRESH(); if ((step == 0) != ((F.vcu & 1) != 0)) ph_conv(F, l); else ph_norm1(F, l, inp(F, IN_X), l != 0); __syncthreads(); } }
        SEAM(0);
        if (IN(1)) ONCE() { FRESH();
            { pg8::Gemm g{(const bf16_t*)(F.ws + WS_XB), (const bf16_t*)(F.ws + WS_WIN), DM, DM, DM}; pg8::DenseOrder S; S.init(T, 3072, F.G, (int)blockIdx.x, DM, DM);
              EpiIn E{F.ws, inp(F, IN_QG) + l * DQK, inp(F, IN_KG) + l * DQK, (LAS float*)(F.lds + RING_BYTES), F.wave, (const float*)(F.ws + WS_RSTD)};
              pg8::gemm_phase<EpiIn, pg8::DenseOrder, false>(F.lds, g, S, E, F.wave); }
            FRESH();
            { pg8::Gemm g{(const bf16_t*)(F.ws + WS_XN8), (const bf16_t*)(F.ws + WS_WG8), DM / 2, DM / 2, DM / 2}; pg8::DenseOrder S; S.init(T, 5120, F.G, (int)blockIdx.x, DM / 2, DM / 2);
              EpiGate E{F.ws, (const float*)(F.ws + WS_RSTD)};
              pg8::gemm_phase<EpiGate, pg8::DenseOrder, false, true>(F.lds, g, S, E, F.wave); }
        }
        SEAM(1);
        if (IN(2)) ONCE() { FRESH();
            pg8::Gemm g{(const bf16_t*)(F.ws + WS_AUG), (const bf16_t*)(F.ws + WS_WST), KAUG, CL * SG, CL * SG}; pg8::BatchOrder S; S.init(RG / 256, 1, NG, F.G, F.vcu, KAUG, CL * SG, RG, 256);
            EpiBf16Z E{(bf16_t*)(F.ws + WS_HLOC), 256, (size_t)RG * 256};
            pg8::gemm_phase<EpiBf16Z, pg8::BatchOrder, false>(F.lds, g, S, E, F.wave);
        }
        SEAM(2);
        if (IN(3)) ONCE() { FRESH(); ph_horner(F, l); __syncthreads(); ph_attn(F, l); }
        SEAM(3);
        if (IN(4)) ONCE() { FRESH();
            pg8::Gemm g{(const bf16_t*)(F.ws + WS_AUG), (const bf16_t*)(F.ws + WS_TM), KAUG, KAUG, KAUG}; pg8::BatchOrder S; S.init(RG / 256, (CL * SG) / 256, NG, F.G, F.vcu, KAUG, KAUG, RG, CL * SG);
            EpiS5 E{(const bf16_t*)(F.ws + WS_AUG), inp(F, IN_SD) + (size_t)l * SW, (bf16_t*)(F.ws + WS_K)};
            pg8::gemm_phase<EpiS5, pg8::BatchOrder, false>(F.lds, g, S, E, F.wave);
        }
        SEAM(4);
        if (IN(5)) ONCE() { FRESH();
            pg8::Gemm g{(const bf16_t*)(F.ws + WS_K), (const bf16_t*)(F.ws + WS_WGLU), SW, SW, SW}; pg8::DenseOrder S; S.init(T, SW, F.G, (int)blockIdx.x, SW, SW);
            EpiMul<0> E{(const void*)(F.ws + WS_K), (bf16_t*)(F.ws + WS_V), SW};
            pg8::gemm_phase<EpiMul<0>, pg8::DenseOrder, false>(F.lds, g, S, E, F.wave);
        }
        SEAM(5);
        if (IN(6)) ONCE() { FRESH();
            static_assert(WS_V > WS_O && WS_WSUP > WS_WAUP, "chained UP operands: offsets relative to the lower buffer");
            { pg8::Gemm g{(const bf16_t*)(F.ws + WS_O), (const bf16_t*)(F.ws + WS_WAUP), AW, AW, AW};
              pg8::ChainOrder S; S.D.init(T, DM, F.G, (int)blockIdx.x, AW, AW); S.aoff0 = 0u; S.aoff1 = (unsigned)(WS_V - WS_O); S.boff0 = 0; S.boff1 = (size_t)(WS_WSUP - WS_WAUP);
              EpiUp E{F.ws + WS_GA, F.ws + WS_GB, (bf16_t*)(F.ws + WS_XN)};
              pg8::gemm_phase<EpiUp, pg8::ChainOrder, false>(F.lds, g, S, E, F.wave); }
        }
        SEAM(6);
        if (IN(7)) ONCE() { FRESH();
            pg8::Gemm g{(const bf16_t*)(F.ws + WS_XN), (const bf16_t*)(F.ws + WS_WOUT), DM, DM, DM}; pg8::DenseOrder S; S.init(T, DM, F.G, (int)blockIdx.x, DM, DM);
            EpiRes E{nullptr, (const bf16_t*)(F.ws + WS_XB), (bf16_t*)(F.ws + WS_XB)};
            pg8::gemm_phase<EpiRes, pg8::DenseOrder, false>(F.lds, g, S, E, F.wave);
        }
        SEAM(7);
        if (IN(8)) { FRESH(); ph_norm2_route(F, l); }
        SEAM(8);
        if (IN(9)) { FRESH(); ph_route2(F, l); }
        SEAM(9);
        if (IN(10)) ONCE() { FRESH();
            const int* tiles = (const int*)(F.ws + WS_TILES);
            pg8::Gemm g{(const bf16_t*)(F.ws + WS_XN), (const bf16_t*)(F.ws + WS_W13), DM / 2, DM / 2, DM / 2};
            pg8::MoeOrder S{tiles, (const int*)(F.ws + WS_ROWMAP), 0, __builtin_amdgcn_readfirstlane(tiles[2 * MAXTILES + 2]), (2 * FF) / 256, F.G, F.vcu, DM / 2, DM / 2, 2 * FF, true};
            EpiSwiglu E{F.ws + WS_HID};
            pg8::gemm_phase<EpiSwiglu, pg8::MoeOrder, true, true>(F.lds, g, S, E, F.wave);
        }
        SEAM(10);
        if (IN(11)) ONCE() { FRESH(); moe_w2(F); }
        if (l + 1 < DEPTH) { SEAM(11); }
        else { if (IN(11) && IN(12)) GRID_BAR();
               if (IN(12)) { FRESH(); ph_combine(F); } }
#undef IN
#undef SEAM
    }
}


extern "C" void kernel_launch(void* const* d_in, const int* in_sizes, int n_in, void* d_out, int out_size, void* d_ws, size_t ws_size, hipStream_t stream) {
    static int grid = 0;
    if (grid == 0) {
        if (n_in != 30 || in_sizes[0] != T * DM || out_size != T * DM || ws_size < WS_END) { fprintf(stderr, "kernel_launch: shape mismatch (n_in %d, in0 %d, out %d, ws %zu < %zu)\n", n_in, n_in > 0 ? in_sizes[0] : -1, out_size, ws_size, (size_t)WS_END); grid = -1; return; }
        int dev = 0, cus = 0, per_cu = 0;
        if (hipGetDevice(&dev) != hipSuccess || hipDeviceGetAttribute(&cus, hipDeviceAttributeMultiprocessorCount, dev) != hipSuccess) { grid = -1; return; }
        if (hipFuncSetAttribute((const void*)fwd, hipFuncAttributeMaxDynamicSharedMemorySize, LDS_BYTES) != hipSuccess) { fprintf(stderr, "kernel_launch: hipFuncSetAttribute failed\n"); grid = -1; return; }
        if (hipOccupancyMaxActiveBlocksPerMultiprocessor(&per_cu, (const void*)fwd, NWAVES * 64, LDS_BYTES) != hipSuccess || per_cu < 1) fprintf(stderr, "kernel_launch: occupancy query says %d\n", per_cu);
        (void)hipGetLastError();
        grid = cus;
    }
    if (grid < 0) return;
    if (hipMemsetAsync((char*)d_ws + WS_CTL, 0, CTL_ZERO_BYTES, stream) != hipSuccess) return;
    Args a{};
    for (int i = 0; i < 30; ++i) a.in[i] = (const float*)d_in[i];
    a.out = (float*)d_out; a.ws = (unsigned char*)d_ws;
#if MK_PER_PHASE
#ifndef DBG_NPH
#define DBG_NPH N_PHASES
#endif
    for (int p = 0; p < DBG_NPH; ++p) { a.ph_lo = p; a.ph_hi = p + 1; hipLaunchKernelGGL(fwd, dim3(grid), dim3(NWAVES * 64), LDS_BYTES, stream, a); }
#else
    a.ph_lo = 0; a.ph_hi = N_PHASES; hipLaunchKernelGGL(fwd, dim3(grid), dim3(NWAVES * 64), LDS_BYTES, stream, a);
#endif
    const hipError_t le = hipPeekAtLastError();
    if (le != hipSuccess) fprintf(stderr, "kernel_launch: launch failed: %s\n", hipGetErrorName(le));
}
```
